# Optimizing an MI355X kernel written in HIP

```python
import math
import jax, jax.numpy as jnp
from jax import lax
import numpy as np

D_MODEL = 1024
BATCH = 16
SEQ = 256
DEPTH = 2
DEC_BATCH = 4
DEC_SEQ = 4096
PAST_LEN = 256

GRID_W = 64
POOL_WINDOWS = (2, 4, 8, 16)
POOL_WIDTH = D_MODEL // 4
POOL_GROUP = POOL_WIDTH // len(POOL_WINDOWS)
HEAD_DIM = 64
N_HEADS = (D_MODEL // 2) // HEAD_DIM
N_KV_HEADS = 2
GQA_GROUP = N_HEADS // N_KV_HEADS
ATTN_WIDTH = N_HEADS * HEAD_DIM
KV_WIDTH = N_KV_HEADS * HEAD_DIM
WINDOW = 128
BLOCK = 128
ROPE_THETA = 10000.0
HY_WIDTH = D_MODEL - POOL_WIDTH - ATTN_WIDTH
HY_ORDER = 2
HY_EMB_DIM = 33
HY_FILTER_HIDDEN = 64
HY_MOD_SHIFT = 0.05
D_FF = 2816
IN_WIDTH = POOL_WIDTH + ATTN_WIDTH + 2 * KV_WIDTH + (HY_ORDER + 1) * HY_WIDTH
N_MOD = 9
NORM_EPS = 1e-6
NEG_INF = -1e30

kernel_name = "hybrid_pool_swa_hyena_diffusion_step"

F32 = jnp.float32


def rmsnorm(x, g):
    xf = x.astype(F32)
    y = xf * lax.rsqrt(jnp.mean(xf * xf, axis=-1, keepdims=True) + NORM_EPS)
    return (y * g.astype(F32)).astype(x.dtype)


def swiglu(h, wg, wu, wd):
    return (jax.nn.silu(h @ wg) * (h @ wu)) @ wd


def pool_mixer(u, w, scale):
    B, L, _ = u.shape
    uf = u.astype(F32)
    cs = jnp.concatenate([jnp.zeros((B, 1, POOL_WIDTH), F32), jnp.cumsum(uf, axis=1)], axis=1)
    t = jnp.arange(L)
    outs = []
    for gi, win in enumerate(POOL_WINDOWS):
        lo = jnp.clip(t - win // 2, 0, L)
        hi = jnp.clip(t + win // 2, 0, L)
        csg = cs[..., gi * POOL_GROUP:(gi + 1) * POOL_GROUP]
        mean = (csg[:, hi] - csg[:, lo]) / (hi - lo).astype(F32)[None, :, None]
        outs.append(mean - uf[..., gi * POOL_GROUP:(gi + 1) * POOL_GROUP])
    d = jnp.stack(outs, axis=2)
    y = jnp.einsum('blgc,gcd->blgd', d, w.astype(F32)).reshape(B, L, POOL_WIDTH)
    return (y * scale.astype(F32)).astype(u.dtype)


def axial_rope(x, pos_row, pos_col):
    half = HEAD_DIM // 2
    quarter = half // 2
    inv = ROPE_THETA ** (-jnp.arange(quarter, dtype=F32) / quarter)

    def rot(xa, pos):
        ang = pos.astype(F32)[:, None] * inv[None, :]
        cos = jnp.cos(ang)[None, :, None, :]
        sin = jnp.sin(ang)[None, :, None, :]
        x1, x2 = xa[..., :quarter], xa[..., quarter:]
        return jnp.concatenate([x1 * cos - x2 * sin, x2 * cos + x1 * sin], axis=-1)

    xf = x.astype(F32)
    return jnp.concatenate([rot(xf[..., :half], pos_row), rot(xf[..., half:], pos_col)], axis=-1).astype(x.dtype)


def context_attention(q, k, v, sink):
    B, Lc = q.shape[:2]
    nb = Lc // BLOCK
    qb = q.reshape(B, nb, BLOCK, N_KV_HEADS, GQA_GROUP, HEAD_DIM).transpose(1, 0, 2, 3, 4, 5)
    sink_b = jnp.broadcast_to(sink.astype(F32).reshape(1, N_KV_HEADS, GQA_GROUP, 1, 1),
                              (B, N_KV_HEADS, GQA_GROUP, BLOCK, 1))
    scale = HEAD_DIM ** -0.5

    def one_block(qi):
        s = jnp.einsum('bqkgd,bckd->bkgqc', qi, k, preferred_element_type=F32) * scale
        p = jax.nn.softmax(jnp.concatenate([s, sink_b], axis=-1), axis=-1)[..., :Lc]
        return jnp.einsum('bkgqc,bckd->bqkgd', p.astype(v.dtype), v, preferred_element_type=F32)

    out = lax.map(one_block, qb)
    return out.transpose(1, 0, 2, 3, 4, 5).reshape(B, Lc, ATTN_WIDTH).astype(q.dtype)


def latent_attention(q, k, v, k_ctx, v_ctx, sink):
    B, L = q.shape[:2]
    Lc = k_ctx.shape[1]
    nb = L // BLOCK
    qb = q.reshape(B, nb, BLOCK, N_KV_HEADS, GQA_GROUP, HEAD_DIM).transpose(1, 0, 2, 3, 4, 5)

    def windows(a):
        ap = jnp.pad(a, ((0, 0), (BLOCK, BLOCK), (0, 0), (0, 0))).reshape(B, nb + 2, BLOCK, N_KV_HEADS, HEAD_DIM)
        w = jnp.concatenate([ap[:, :-2], ap[:, 1:-1], ap[:, 2:]], axis=2)
        return w.transpose(1, 0, 2, 3, 4)

    kw, vw = windows(k), windows(v)
    nidx = jnp.arange(nb)[:, None, None]
    qpos = nidx * BLOCK + jnp.arange(BLOCK)[None, :, None]
    kpos = (nidx - 1) * BLOCK + jnp.arange(3 * BLOCK)[None, None, :]
    valid = (jnp.abs(kpos - qpos) <= WINDOW) & (kpos >= 0) & (kpos < L)
    sink_b = jnp.broadcast_to(sink.astype(F32).reshape(1, N_KV_HEADS, GQA_GROUP, 1, 1),
                              (B, N_KV_HEADS, GQA_GROUP, BLOCK, 1))
    scale = HEAD_DIM ** -0.5

    def one_block(args):
        qi, ki, vi, mi = args
        s_loc = jnp.einsum('bqkgd,bjkd->bkgqj', qi, ki, preferred_element_type=F32) * scale
        s_loc = jnp.where(mi, s_loc, NEG_INF)
        s_ctx = jnp.einsum('bqkgd,bckd->bkgqc', qi, k_ctx, preferred_element_type=F32) * scale
        p = jax.nn.softmax(jnp.concatenate([s_loc, s_ctx, sink_b], axis=-1), axis=-1).astype(v.dtype)
        o_loc = jnp.einsum('bkgqj,bjkd->bqkgd', p[..., :3 * BLOCK], vi, preferred_element_type=F32)
        o_ctx = jnp.einsum('bkgqc,bckd->bqkgd', p[..., 3 * BLOCK:3 * BLOCK + Lc], v_ctx, preferred_element_type=F32)
        return o_loc + o_ctx

    out = lax.map(one_block, (qb, kw, vw, valid))
    return out.transpose(1, 0, 2, 3, 4, 5).reshape(B, L, ATTN_WIDTH).astype(q.dtype)


def hyena_filters(L, w1, b1, w2, b2, w3, b3, freq, deltas):
    t = jnp.linspace(0.0, 1.0, L, dtype=F32)[:, None]
    bands = (HY_EMB_DIM - 1) // 2
    f = jnp.linspace(1e-4, bands - 1, bands, dtype=F32)[None, :]
    w = 2.0 * math.pi * jnp.arange(L, dtype=F32)[:, None] / L
    z = jnp.concatenate([t, jnp.cos(f * w), -jnp.sin(f * w)], axis=-1)
    fr = freq.astype(F32)
    h = jnp.sin(fr[0] * (z @ w1.astype(F32) + b1.astype(F32)))
    h = jnp.sin(fr[1] * (h @ w2.astype(F32) + b2.astype(F32)))
    h = (h @ w3.astype(F32) + b3.astype(F32)).reshape(L, 2, HY_ORDER, HY_WIDTH)
    decay = jnp.exp(-t[:, :, None, None] * jnp.abs(deltas.astype(F32))[None, None])
    h = h * (decay + HY_MOD_SHIFT)
    fwd, bwd = h[:, 0], h[:, 1]
    k = jnp.concatenate([fwd, jnp.zeros((1, HY_ORDER, HY_WIDTH), F32), jnp.flip(bwd[1:], axis=0)], axis=0)
    return k / (jnp.sum(jnp.abs(k), axis=0, keepdims=True) + 1e-6)


def short_conv(u, w, b):
    up = jnp.pad(u, ((0, 0), (1, 1), (0, 0)))
    return up[:, :-2] * w[0] + up[:, 1:-1] * w[1] + up[:, 2:] * w[2] + b


def fft_conv(z, k):
    L = z.shape[1]
    zf = jnp.fft.rfft(z, n=2 * L, axis=1)
    kf = jnp.fft.rfft(k, n=2 * L, axis=0)
    return jnp.fft.irfft(zf * kf[None], n=2 * L, axis=1)[:, :L]


def hyena_mixer(u, sw, sb, filt, bias_d):
    uc = short_conv(u, sw, sb).astype(F32)
    v, x1, x2 = jnp.split(uc, 3, axis=-1)
    bd = bias_d.astype(F32)
    z = v
    for o, gate in enumerate((x1, x2)):
        z = gate * (fft_conv(z, filt[:, o]) + bd[o] * z)
    return z.astype(u.dtype)


def trunk_layer(x, cond, p, pos, ctx_kv):
    B, L, _ = x.shape
    mod = (jax.nn.silu(cond.astype(F32)) @ p['ada_w'].astype(F32) + p['ada_b'].astype(F32)).astype(x.dtype)
    sh1, sc1, g1, sh2, sc2, g2, sh3, sc3, g3 = jnp.split(mod[:, None, :], N_MOD, axis=-1)

    h = rmsnorm(x, p['norm'][0]) * (1 + sc1) + sh1
    x = x + 0.5 * g1 * swiglu(h, p['wg'][0], p['wu'][0], p['wd'][0])

    h = rmsnorm(x, p['norm'][1]) * (1 + sc2) + sh2
    u = h @ p['w_in']
    s1 = POOL_WIDTH
    s2 = s1 + ATTN_WIDTH
    s3 = s2 + KV_WIDTH
    s4 = s3 + KV_WIDTH
    u_pool, q, k, v, u_hy = jnp.split(u, [s1, s2, s3, s4], axis=-1)
    q = rmsnorm(q.reshape(B, L, N_HEADS, HEAD_DIM), p['q_norm'])
    k = rmsnorm(k.reshape(B, L, N_KV_HEADS, HEAD_DIM), p['k_norm'])
    v = v.reshape(B, L, N_KV_HEADS, HEAD_DIM)
    if ctx_kv is None:
        a = context_attention(q, k, v, p['sink'])
        new_kv = (k, v)
    else:
        q = axial_rope(q, pos[0], pos[1])
        k = axial_rope(k, pos[0], pos[1])
        a = latent_attention(q, k, v, ctx_kv[0], ctx_kv[1], p['sink'])
        new_kv = None
    y_pool = pool_mixer(u_pool, p['pool_w'], p['pool_scale'])
    filt = hyena_filters(L, p['f_w1'], p['f_b1'], p['f_w2'], p['f_b2'], p['f_w3'], p['f_b3'], p['f_freq'], p['decay'])
    y_hy = hyena_mixer(u_hy, p['short_w'], p['short_b'], filt, p['hy_bias'])
    mix = jnp.concatenate([y_pool, a, y_hy], axis=-1) @ p['w_out']
    x = x + g2 * mix

    h = rmsnorm(x, p['norm'][2]) * (1 + sc3) + sh3
    x = x + 0.5 * g3 * swiglu(h, p['wg'][1], p['wu'][1], p['wd'][1])
    return x, new_kv


def setup_inputs(seed: int = 0) -> dict:
    key = jax.random.key(seed)
    ks = jax.random.split(key, 40)

    def nrm(k, shape, s):
        return jax.random.normal(k, shape, F32) * s

    base_decay = jnp.linspace(abs(math.log(1e-2) / 1.5), abs(math.log(1e-2) / 0.3), HY_WIDTH, dtype=F32)
    return {
        "x_prompt": nrm(ks[0], (BATCH, SEQ, D_MODEL), 1.0),
        "x_sample": nrm(ks[1], (DEC_BATCH, DEC_SEQ, D_MODEL), 1.0),
        "cache_k": nrm(ks[2], (DEC_BATCH, DEPTH, PAST_LEN, N_KV_HEADS, HEAD_DIM), 1.0),
        "cache_v": nrm(ks[3], (DEC_BATCH, DEPTH, PAST_LEN, N_KV_HEADS, HEAD_DIM), 1.0),
        "c": nrm(ks[4], (DEC_BATCH, D_MODEL), 1.0),
        "c_ctx": nrm(ks[5], (D_MODEL,), 1.0),
        "ada_w": nrm(ks[6], (DEPTH, D_MODEL, N_MOD * D_MODEL), 0.5 * D_MODEL ** -0.5),
        "ada_b": nrm(ks[7], (DEPTH, N_MOD * D_MODEL), 0.02),
        "norm_w": 1.0 + nrm(ks[8], (DEPTH, 3, D_MODEL), 0.05),
        "ffn_wg": nrm(ks[9], (DEPTH, 2, D_MODEL, D_FF), D_MODEL ** -0.5),
        "ffn_wu": nrm(ks[10], (DEPTH, 2, D_MODEL, D_FF), D_MODEL ** -0.5),
        "ffn_wd": nrm(ks[11], (DEPTH, 2, D_FF, D_MODEL), D_FF ** -0.5),
        "w_in": nrm(ks[12], (DEPTH, D_MODEL, IN_WIDTH), D_MODEL ** -0.5),
        "w_out": nrm(ks[13], (DEPTH, D_MODEL, D_MODEL), D_MODEL ** -0.5),
        "pool_w": nrm(ks[14], (DEPTH, len(POOL_WINDOWS), POOL_GROUP, POOL_GROUP), POOL_GROUP ** -0.5),
        "pool_scale": 1.0 + nrm(ks[15], (DEPTH, POOL_WIDTH), 0.1),
        "q_norm": 1.0 + nrm(ks[16], (DEPTH, HEAD_DIM), 0.05),
        "k_norm": 1.0 + nrm(ks[17], (DEPTH, HEAD_DIM), 0.05),
        "attn_sink": nrm(ks[18], (DEPTH, N_HEADS), 0.5),
        "hy_short_w": nrm(ks[19], (DEPTH, 3, (HY_ORDER + 1) * HY_WIDTH), 3 ** -0.5),
        "hy_short_b": nrm(ks[20], (DEPTH, (HY_ORDER + 1) * HY_WIDTH), 0.02),
        "hy_f_w1": nrm(ks[21], (DEPTH, HY_EMB_DIM, HY_FILTER_HIDDEN), HY_EMB_DIM ** -0.5),
        "hy_f_b1": nrm(ks[22], (DEPTH, HY_FILTER_HIDDEN), 0.1),
        "hy_f_w2": nrm(ks[23], (DEPTH, HY_FILTER_HIDDEN, HY_FILTER_HIDDEN), HY_FILTER_HIDDEN ** -0.5),
        "hy_f_b2": nrm(ks[24], (DEPTH, HY_FILTER_HIDDEN), 0.1),
        "hy_f_w3": nrm(ks[25], (DEPTH, HY_FILTER_HIDDEN, 2 * HY_ORDER * HY_WIDTH), HY_FILTER_HIDDEN ** -0.5),
        "hy_f_b3": nrm(ks[26], (DEPTH, 2 * HY_ORDER * HY_WIDTH), 0.02),
        "hy_sin_freq": 1.0 + nrm(ks[27], (DEPTH, 2, HY_FILTER_HIDDEN), 0.1),
        "hy_decay": base_decay[None, None, :] + nrm(ks[28], (DEPTH, HY_ORDER, HY_WIDTH), 0.1),
        "hy_bias": nrm(ks[29], (DEPTH, HY_ORDER, HY_WIDTH), 1.0),
    }


def reference(x_prompt, x_sample, cache_k, cache_v, c, c_ctx, ada_w, ada_b, norm_w,
              ffn_wg, ffn_wu, ffn_wd, w_in, w_out, pool_w, pool_scale, q_norm, k_norm,
              attn_sink, hy_short_w, hy_short_b, hy_f_w1, hy_f_b1, hy_f_w2, hy_f_b2,
              hy_f_w3, hy_f_b3, hy_sin_freq, hy_decay, hy_bias):
    L_lat = x_sample.shape[1]
    n_rows = L_lat // GRID_W
    t = jnp.arange(n_rows * GRID_W)
    pos = (t // GRID_W, t % GRID_W)
    cond_ctx = c_ctx[None, :]
    yp, ys = x_prompt, x_sample
    ks, vs = [], []
    for l in range(DEPTH):
        p = {
            'ada_w': ada_w[l], 'ada_b': ada_b[l], 'norm': norm_w[l],
            'wg': ffn_wg[l], 'wu': ffn_wu[l], 'wd': ffn_wd[l],
            'w_in': w_in[l], 'w_out': w_out[l],
            'pool_w': pool_w[l], 'pool_scale': pool_scale[l],
            'q_norm': q_norm[l], 'k_norm': k_norm[l], 'sink': attn_sink[l],
            'short_w': hy_short_w[l], 'short_b': hy_short_b[l],
            'f_w1': hy_f_w1[l], 'f_b1': hy_f_b1[l], 'f_w2': hy_f_w2[l], 'f_b2': hy_f_b2[l],
            'f_w3': hy_f_w3[l], 'f_b3': hy_f_b3[l], 'f_freq': hy_sin_freq[l],
            'decay': hy_decay[l], 'hy_bias': hy_bias[l],
        }
        yp, kv = trunk_layer(yp, cond_ctx, p, None, None)
        ks.append(kv[0])
        vs.append(kv[1])
        ys, _ = trunk_layer(ys, c, p, pos, (cache_k[:, l], cache_v[:, l]))
    new_cache_k = jnp.stack(ks, axis=1)
    new_cache_v = jnp.stack(vs, axis=1)
    return (yp, ys, new_cache_k, new_cache_v)
```

```cpp
#include <hip/hip_runtime.h>
#include <hip/hip_cooperative_groups.h>
#include <cstdio>
namespace cg = cooperative_groups;
namespace pg8 {
#define PG8_LAS __attribute__((address_space(3)))
typedef unsigned short bf16_t;
typedef short bf16x8 __attribute__((ext_vector_type(8)));
typedef float f32x4 __attribute__((ext_vector_type(4)));
typedef unsigned u32x4 __attribute__((ext_vector_type(4)));
constexpr int BM = 256, BK = 64, HALF = 128, HTB = HALF * BK * 2  , STAGE_BYTES = 8 * HTB, NXCD = 8, WGM = 8;
__host__ __device__ __forceinline__ int lds_byte(int r, int c) { const int st = (r >> 4) * 2 + (c >> 5), rr = r & 15, cc = c & 31, ob = rr * 64 + cc * 2; return st * 1024 + (ob ^ (((ob >> 9) & 1) << 5)); }
__host__ __device__ __forceinline__ void stage_rc(int b, int& R, int& C) { const int st = b / 1024, sb = b % 1024, swz = sb ^ (((sb >> 9) & 1) << 5); R = (st >> 1) * 16 + swz / 64; C = (st & 1) * 32 + (swz % 64) / 2; }
__host__ __device__ __forceinline__ int perm32(int rho) { const int n = rho >> 4, i = rho & 15; return 8 * (i >> 2) + 4 * n + (i & 3); }

struct Unit { int pm, pn; };
struct Gemm { const bf16_t* A; const bf16_t* Bt; int M, N, K; };
struct StaticOrder {
    int nM, nN, nwg, G, c;
    __host__ __device__ void init(int M, int N, int G_, int c_) { nM = M / BM; nN = N / BM; nwg = nM * nN; G = G_; c = c_; }
    __host__ __device__ bool next(int i, Unit& u) const {
        const long L = (long)i * G + c; if (L >= nwg) return false;
        int wgid = (int)L; { const int q = nwg / NXCD, r = nwg % NXCD, xcd = wgid % NXCD, off = wgid / NXCD; wgid = (xcd < r ? xcd * (q + 1) : r * (q + 1) + (xcd - r) * q) + off; }
        const int nig = WGM * nN, gid = wgid / nig, fm = gid * WGM, gsz = (nM - fm) < WGM ? (nM - fm) : WGM;
        u.pm = fm + ((wgid % nig) % gsz); u.pn = (wgid % nig) / gsz; return true;
    }
    __device__ __forceinline__ void a_ready(const Unit&) const {}
    __device__ __forceinline__ void done(const Unit&) const {}
};
__device__ __forceinline__ unsigned cvt_pk_bf16(float lo, float hi) { unsigned r; asm volatile("v_cvt_pk_bf16_f32 %0, %1, %2" : "=v"(r) : "v"(lo), "v"(hi)); return r; }
template <class Epi, class Sched>
__device__ __forceinline__ void gemm_phase(PG8_LAS unsigned char* lds, const Gemm g, const Sched& S, const Epi& E) {
    int tid_ = threadIdx.x; asm volatile("" : "+v"(tid_)); const int tid = tid_, wid = __builtin_amdgcn_readfirstlane(tid >> 6), lane = tid & 63, wr = wid >> 2, wc = wid & 3, fr = lane & 15, fq = lane >> 4;
    const int K = g.K, nt = K / BK;
#define PG8_STAMP() do {} while (0)
    unsigned voffA[2], voffB[2];
#pragma unroll
    for (int i = 0; i < 2; ++i) { int R, C; stage_rc(tid * 16 + i * 8192, R, C); const int Rb = Epi::PERM ? ((R & ~31) + perm32(R & 31)) : R;
        voffA[i] = (unsigned)(R * K + C) * 2u; voffB[i] = (unsigned)(Rb * K + C) * 2u; }
    const size_t kstep = (size_t)(BK * 2);
    const size_t hstep = (size_t)HALF * K * 2;
    const size_t tstep = 2 * hstep;
    const unsigned ldsw = (unsigned)wid * 1024u;
    const int aoff = lds_byte(wr * 64 + fr, fq * 8), boff = lds_byte(wc * 32 + fr, fq * 8);
#define PG8_SA(b, h) (((b) * 2 + (h)) * HTB)
#define PG8_SB(b, h) ((4 + (b) * 2 + (h)) * HTB)
#define PG8_STAGE(bufoff, gbase, voff) do { _Pragma("unroll") for (int _i = 0; _i < 2; ++_i) \
        __builtin_amdgcn_global_load_lds((const unsigned*)((const char*)(gbase) + (voff)[_i]), (PG8_LAS unsigned*)(lds + (bufoff) + ldsw + _i * 8192), 16, 0, 0); } while (0)
#define PG8_LDA(dst, b, h) do { _Pragma("unroll") for (int m = 0; m < 4; ++m) _Pragma("unroll") for (int k = 0; k < 2; ++k) dst[m][k] = *(const PG8_LAS bf16x8*)(lds + PG8_SA(b, h) + aoff + m * 2048 + k * 1024); } while (0)
#define PG8_LDB(dst, b, h) do { _Pragma("unroll") for (int n = 0; n < 2; ++n) _Pragma("unroll") for (int k = 0; k < 2; ++k) dst[n][k] = *(const PG8_LAS bf16x8*)(lds + PG8_SB(b, h) + boff + n * 2048 + k * 1024); } while (0)
#define PG8_MMA(ai, bj, At, Bt) do { __builtin_amdgcn_s_setprio(1); _Pragma("unroll") for (int m = 0; m < 4; ++m) _Pragma("unroll") for (int n = 0; n < 2; ++n) _Pragma("unroll") for (int k = 0; k < 2; ++k) \
        acc[ai][bj][m][n] = __builtin_amdgcn_mfma_f32_16x16x32_bf16(Bt[n][k], At[m][k], acc[ai][bj][m][n], 0, 0, 0); __builtin_amdgcn_s_setprio(0); } while (0)
#define PG8_WAIT_V(n) asm volatile("s_waitcnt vmcnt(" #n ")" ::: "memory")
#define PG8_WAIT_L(n) asm volatile("s_waitcnt lgkmcnt(" #n ")" ::: "memory")
#define PG8_BAR __builtin_amdgcn_s_barrier()
#define PG8_SCHED __builtin_amdgcn_sched_barrier(0)
    Unit cur, nxt; int ui = 0;
    if (!S.next(0, cur)) return;
    f32x4 acc[2][2][4][2];
#pragma unroll
    for (int a = 0; a < 2; ++a)
#pragma unroll
        for (int b = 0; b < 2; ++b)
#pragma unroll
            for (int m = 0; m < 4; ++m)
#pragma unroll
                for (int n = 0; n < 2; ++n) acc[a][b][m][n] = (f32x4){0.f, 0.f, 0.f, 0.f};
    bf16x8 At[4][2], B0[2][2], B1[2][2];
    const char* cA = (const char*)g.A + (size_t)cur.pm * tstep; const char* cB = (const char*)g.Bt + (size_t)cur.pn * tstep;
    S.a_ready(cur);
    PG8_STAGE(PG8_SB(0, 0), cB, voffB); PG8_STAGE(PG8_SA(0, 0), cA, voffA); PG8_STAGE(PG8_SB(0, 1), cB + hstep, voffB); PG8_STAGE(PG8_SA(0, 1), cA + hstep, voffA);
    if (wr == 1) PG8_BAR;
    PG8_WAIT_V(4); PG8_BAR;
    PG8_STAGE(PG8_SB(1, 0), cB + kstep, voffB); PG8_STAGE(PG8_SA(1, 0), cA + kstep, voffA); PG8_STAGE(PG8_SB(1, 1), cB + hstep + kstep, voffB);
    PG8_WAIT_V(6); PG8_BAR;
    PG8_STAMP();
    for (;;) {
        const bool has_next = S.next(ui + 1, nxt);
        const char* nA = has_next ? (const char*)g.A + (size_t)nxt.pm * tstep : cA; const char* nB = has_next ? (const char*)g.Bt + (size_t)nxt.pn * tstep : cB;
        for (int t = 0; t < nt; t += 2) {
            const bool last = (t == nt - 2);
            const char* a1 = cA + (size_t)(t + 1) * kstep;
            const char* a2 = last ? nA : cA + (size_t)(t + 2) * kstep; const char* b2 = last ? nB : cB + (size_t)(t + 2) * kstep;
            const char* a3 = a2 + kstep; const char* b3 = b2 + kstep;
            if (last && has_next) S.a_ready(nxt);
            PG8_LDB(B0, 0, 0); PG8_SCHED; PG8_LDA(At, 0, 0); PG8_STAGE(PG8_SA(1, 1), a1 + hstep, voffA);
            PG8_WAIT_L(8); PG8_BAR; PG8_WAIT_L(0); PG8_MMA(0, 0, At, B0); PG8_BAR; PG8_SCHED;
            PG8_LDB(B1, 0, 1); PG8_STAGE(PG8_SB(0, 0), b2, voffB);
            PG8_BAR; PG8_WAIT_L(0); PG8_MMA(0, 1, At, B1); PG8_BAR;
            PG8_LDA(At, 0, 1); PG8_STAGE(PG8_SA(0, 0), a2, voffA);
            PG8_BAR; PG8_WAIT_L(0); PG8_MMA(1, 0, At, B0); PG8_BAR; PG8_SCHED;
            PG8_STAGE(PG8_SB(0, 1), b2 + hstep, voffB);
            PG8_WAIT_V(6); PG8_BAR; PG8_MMA(1, 1, At, B1); PG8_BAR;
            PG8_LDB(B0, 1, 0); PG8_SCHED; PG8_LDA(At, 1, 0); PG8_STAGE(PG8_SA(0, 1), a2 + hstep, voffA);
            PG8_WAIT_L(8); PG8_BAR; PG8_WAIT_L(0); PG8_MMA(0, 0, At, B0); PG8_BAR; PG8_SCHED;
            PG8_LDB(B1, 1, 1); PG8_STAGE(PG8_SB(1, 0), b3, voffB);
            PG8_BAR; PG8_WAIT_L(0); PG8_MMA(0, 1, At, B1); PG8_BAR;
            PG8_LDA(At, 1, 1); PG8_STAGE(PG8_SA(1, 0), a3, voffA);
            PG8_BAR; PG8_WAIT_L(0); PG8_MMA(1, 0, At, B0); PG8_BAR; PG8_SCHED;
            PG8_STAGE(PG8_SB(1, 1), b3 + hstep, voffB);
            PG8_WAIT_V(6); PG8_BAR; PG8_MMA(1, 1, At, B1); PG8_BAR;
        }
        PG8_STAMP();
        if constexpr (!Epi::AFTER_DRAIN) { E(acc, cur, wr, wc, fr, fq); S.done(cur); }
        PG8_STAMP();
        if (!has_next) break;
#pragma unroll
        for (int a = 0; a < 2; ++a)
#pragma unroll
            for (int b = 0; b < 2; ++b)
#pragma unroll
                for (int m = 0; m < 4; ++m)
#pragma unroll
                    for (int n = 0; n < 2; ++n) acc[a][b][m][n] = (f32x4){0.f, 0.f, 0.f, 0.f};
        cur = nxt; cA = nA; cB = nB; ++ui;
    }
    PG8_WAIT_V(0);
    if (wr == 0) PG8_BAR;
    PG8_BAR;
    if constexpr (Epi::AFTER_DRAIN) { E.fused(acc, cur, wr, wc, fr, fq, lds, wid, lane); S.done(cur); }
    PG8_STAMP();
#undef PG8_SA
#undef PG8_SB
#undef PG8_STAGE
#undef PG8_LDA
#undef PG8_LDB
#undef PG8_MMA
#undef PG8_WAIT_V
#undef PG8_WAIT_L
#undef PG8_BAR
#undef PG8_SCHED
}
}


#define LAS __attribute__((address_space(3)))
typedef unsigned short bf16_t;
typedef short bf16x8 __attribute__((ext_vector_type(8)));
typedef float f32x4 __attribute__((ext_vector_type(4)));
typedef float f32x16 __attribute__((ext_vector_type(16)));
typedef unsigned u32x4 __attribute__((ext_vector_type(4)));
typedef unsigned u32x2 __attribute__((ext_vector_type(2)));

constexpr int MTOK = 20480, MPR = 4096;
constexpr int NPH = 25;
constexpr int LDS_BYTES = 131072;
constexpr int NTHR = 512;

constexpr size_t SZ_WGU = (size_t)5632 * 1024 * 2, SZ_WD = (size_t)1024 * 2816 * 2, SZ_WIN = (size_t)1792 * 1024 * 2, SZ_WOUT = (size_t)1024 * 1024 * 2;
constexpr size_t WS_WGU = 0;
constexpr size_t WS_WD = WS_WGU + 4 * SZ_WGU;
constexpr size_t WS_WIN = WS_WD + 4 * SZ_WD;
constexpr size_t WS_WOUT = WS_WIN + 2 * SZ_WIN;
constexpr size_t WS_MOD = WS_WOUT + 2 * SZ_WOUT;
constexpr size_t WS_ABUF = WS_MOD + (size_t)2 * 5 * 9216 * 4;
constexpr size_t WS_R = WS_ABUF + (size_t)MTOK * 1024 * 2;
constexpr size_t WS_ACT = WS_R;
constexpr size_t WS_U = WS_R;
constexpr size_t WS_QB = WS_U + (size_t)MTOK * 1792 * 2;
constexpr size_t WS_KB = WS_QB + (size_t)MTOK * 512 * 2;
constexpr size_t WS_VT = WS_KB + (size_t)MTOK * 128 * 2;
constexpr size_t WS_Z1 = WS_VT + (size_t)MTOK * 128 * 2;
constexpr size_t WS_HV = WS_R + (size_t)MTOK * 2816 * 2;
constexpr size_t WS_X1 = WS_HV + (size_t)MTOK * 256 * 2;
constexpr size_t WS_X2 = WS_X1 + (size_t)MTOK * 256 * 2;
constexpr size_t WS_FILT = WS_X2 + (size_t)MTOK * 256 * 2;
constexpr size_t SZ_FILT_S = (size_t)2 * 256 * 8192 * 2, SZ_FILT_P = (size_t)2 * 256 * 512 * 2, SZ_FILT_L = SZ_FILT_S + SZ_FILT_P;
constexpr size_t WS_FSC = WS_FILT + 2 * SZ_FILT_L;
constexpr size_t WS_H2 = WS_FSC + (size_t)2 * 2 * 2 * 256 * 4;
constexpr size_t WS_KC = WS_H2 + (size_t)2 * 4352 * 64 * 4;
constexpr size_t WS_VCT = WS_KC + (size_t)2 * 4 * 256 * 128 * 2;
constexpr size_t WS_END = WS_VCT + (size_t)2 * 4 * 256 * 128 * 2;
static_assert(WS_Z1 + (size_t)MTOK * 256 * 2 <= WS_HV, "alias region overflow");

constexpr size_t OUT_K = (size_t)MTOK * 1024, OUT_V = OUT_K + (size_t)16 * 2 * 256 * 128;

struct Params { const float* in[30]; float* out; unsigned char* ws; int ph_lo, ph_hi; };

__device__ __forceinline__ int otid() { int t = threadIdx.x; asm volatile("" : "+v"(t)); return t; }
__device__ __forceinline__ float bf2f(bf16_t b) { return __uint_as_float(((unsigned)b) << 16); }
__device__ __forceinline__ float bflo(unsigned w) { return __uint_as_float(w << 16); }
__device__ __forceinline__ float bfhi(unsigned w) { return __uint_as_float(w & 0xffff0000u); }
__device__ __forceinline__ unsigned pk(float lo, float hi) { return pg8::cvt_pk_bf16(lo, hi); }
__device__ __forceinline__ bf16_t f2bf(float f) { return (bf16_t)(pk(f, 0.f) & 0xffffu); }
__device__ __forceinline__ void unpack8(const u32x4 w, float* x) { x[0] = bflo(w.x); x[1] = bfhi(w.x); x[2] = bflo(w.y); x[3] = bfhi(w.y); x[4] = bflo(w.z); x[5] = bfhi(w.z); x[6] = bflo(w.w); x[7] = bfhi(w.w); }
__device__ __forceinline__ u32x4 pack8(const float* x) { u32x4 w; w.x = pk(x[0], x[1]); w.y = pk(x[2], x[3]); w.z = pk(x[4], x[5]); w.w = pk(x[6], x[7]); return w; }

__device__ void mod_item(const Params& p, LAS unsigned char* lds, int it) {
    const int tid = otid(), l = it / 72, nt = it % 72;
    LAS float* sc = (LAS float*)lds;
    LAS float* red = (LAS float*)(lds + 20480);
    for (int i = tid; i < 5 * 1024; i += NTHR) { const int ci = i >> 10, k = i & 1023; const float v = ci == 0 ? p.in[5][k] : p.in[4][(ci - 1) * 1024 + k]; sc[i] = v / (1.f + expf(-v)); }
    __syncthreads();
    const int cq = tid & 31, kg = tid >> 5;
    const float* W = p.in[6] + (size_t)l * 1024 * 9216 + nt * 128 + cq * 4;
    f32x4 acc[5];
#pragma unroll
    for (int ci = 0; ci < 5; ++ci) acc[ci] = (f32x4){0.f, 0.f, 0.f, 0.f};
#pragma unroll 4
    for (int kk = 0; kk < 64; ++kk) { const int k = kg * 64 + kk; const f32x4 w = *(const f32x4*)(W + (size_t)k * 9216);
#pragma unroll
        for (int ci = 0; ci < 5; ++ci) acc[ci] += sc[ci * 1024 + k] * w; }
#pragma unroll
    for (int ci = 0; ci < 5; ++ci)
#pragma unroll
        for (int j = 0; j < 4; ++j) red[(kg * 5 + ci) * 128 + cq * 4 + j] = acc[ci][j];
    __syncthreads();
    float* mod = (float*)(p.ws + WS_MOD);
    for (int i = tid; i < 640; i += NTHR) { const int ci = i >> 7, n = i & 127; float s = 0.f;
#pragma unroll
        for (int g = 0; g < 16; ++g) s += red[(g * 5 + ci) * 128 + n];
        mod[(size_t)(l * 5 + ci) * 9216 + nt * 128 + n] = s + p.in[7][l * 9216 + nt * 128 + n]; }
    __syncthreads();
}

__device__ void h2_item(const Params& p, int idx) {
    const int tid = otid(), lane = tid & 63, wave = tid >> 6;
    const int rowid = idx * 8 + wave, l = rowid / 4352, rr = rowid % 4352, Lsel = rr < 256 ? 0 : 1, t = Lsel ? rr - 256 : rr, L = Lsel ? 4096 : 256;
    float zv = 0.f;
    { const float tl = (float)t / (float)(L - 1); const float w = 6.283185307179586f * (float)t / (float)L;
      if (lane == 0) zv = tl;
      else if (lane <= 16) { const float f = 1e-4f + (float)(lane - 1) * ((15.f - 1e-4f) / 15.f); zv = cosf(f * w); }
      else if (lane <= 32) { const float f = 1e-4f + (float)(lane - 17) * ((15.f - 1e-4f) / 15.f); zv = -sinf(f * w); } }
    const float* w1 = p.in[21] + l * 33 * 64; const float* w2 = p.in[23] + l * 4096; const float* fr = p.in[27] + l * 128;
    float a = 0.f;
    for (int e = 0; e < 33; ++e) a += __shfl(zv, e) * w1[e * 64 + lane];
    a = sinf(fr[lane] * (a + p.in[22][l * 64 + lane]));
    float b = 0.f;
    for (int i = 0; i < 64; ++i) b += __shfl(a, i) * w2[i * 64 + lane];
    b = sinf(fr[64 + lane] * (b + p.in[24][l * 64 + lane]));
    ((float*)(p.ws + WS_H2))[((size_t)l * 4352 + rr) * 64 + lane] = b;
}

__device__ void cache_item(const Params& p, int idx) {
    const int tid = otid();
    const bool isv = idx >= 64; const int base = (idx & 63) * 4096;
    bf16_t* dst = (bf16_t*)(p.ws + (isv ? WS_VCT : WS_KC)); const float* src = p.in[isv ? 3 : 2];
#pragma unroll
    for (int i = 0; i < 8; ++i) { const int o = base + i * 512 + tid; int l, b, s, e;
        if (!isv) { e = o & 127; s = (o >> 7) & 255; b = (o >> 15) & 3; l = o >> 17; }
        else { s = o & 255; e = (o >> 8) & 127; b = (o >> 15) & 3; l = o >> 17; }
        dst[o] = f2bf(src[((size_t)(b * 2 + l) * 256 + s) * 128 + e]); }
}

__device__ void transpose_item(const Params& p, LAS unsigned char* lds, int idx) {
    const int tid = otid();
    const int l = idx / 4928, rem = idx % 4928; const float* src; bf16_t* dst; int K, N, kt, nt, mode = 0;
    if (rem < 4224) { const int f = rem / 2112, r2 = rem % 2112, kind = r2 / 704, t = r2 % 704, lf = l * 2 + f;
        if (kind < 2) { src = p.in[9 + kind] + (size_t)lf * 1024 * 2816; K = 1024; N = 2816; kt = t / 44; nt = t % 44; dst = (bf16_t*)(p.ws + WS_WGU + lf * SZ_WGU); mode = 1 + kind; }
        else { src = p.in[11] + (size_t)lf * 2816 * 1024; K = 2816; N = 1024; kt = t / 16; nt = t % 16; dst = (bf16_t*)(p.ws + WS_WD + lf * SZ_WD); } }
    else if (rem < 4672) { const int t = rem - 4224; src = p.in[12] + (size_t)l * 1024 * 1792; K = 1024; N = 1792; kt = t / 28; nt = t % 28; dst = (bf16_t*)(p.ws + WS_WIN + l * SZ_WIN); }
    else { const int t = rem - 4672; src = p.in[13] + (size_t)l * 1024 * 1024; K = 1024; N = 1024; kt = t / 16; nt = t % 16; dst = (bf16_t*)(p.ws + WS_WOUT + l * SZ_WOUT); }
    LAS float* T = (LAS float*)lds;
#pragma unroll
    for (int i = 0; i < 2; ++i) { const int e = tid + i * 512, kr = e >> 4, c4 = e & 15; const f32x4 v = *(const f32x4*)(src + (size_t)(kt * 64 + kr) * N + nt * 64 + c4 * 4);
#pragma unroll
        for (int j = 0; j < 4; ++j) T[kr * 65 + c4 * 4 + j] = v[j]; }
    __syncthreads();
    { const int n = tid >> 3, kc = tid & 7, ng = nt * 64 + n; const int drow = mode == 0 ? ng : ((ng >> 4) * 32 + (mode == 2 ? 16 : 0) + (ng & 15));
      float x[8];
#pragma unroll
      for (int j = 0; j < 8; ++j) x[j] = T[(kc * 8 + j) * 65 + n];
      *(u32x4*)(dst + (size_t)drow * K + kt * 64 + kc * 8) = pack8(x); }
    __syncthreads();
}

__device__ void ph_prep(const Params& p, LAS unsigned char* lds) {
    constexpr int N_MOD = 144, N_H2 = 1088, N_CACHE = 128, N_TR = 9856;
    for (int it = blockIdx.x; it < N_MOD + N_H2 + N_CACHE + N_TR; it += gridDim.x) {
        if (it < N_MOD) mod_item(p, lds, it);
        else if (it < N_MOD + N_H2) h2_item(p, it - N_MOD);
        else if (it < N_MOD + N_H2 + N_CACHE) cache_item(p, it - N_MOD - N_H2);
        else transpose_item(p, lds, it - N_MOD - N_H2 - N_CACHE);
    }
}

__device__ __forceinline__ bf16_t* filt_ptr(const Params& p, int l, int Lsel) { return (bf16_t*)(p.ws + WS_FILT + l * SZ_FILT_L + (Lsel ? 0 : SZ_FILT_S)); }

__device__ void filter_item(const Params& p, LAS unsigned char* lds, int fidx) {
    const int tid = otid(), lane = tid & 63, wave = tid >> 6;
    const int Lsel = fidx < 256 ? 1 : 0, f2 = fidx & 255, l = f2 >> 7, o = (f2 >> 6) & 1, cg4 = f2 & 63, L = Lsel ? 4096 : 256;
    LAS float* w3s = (LAS float*)lds;
    LAS float* red = (LAS float*)(lds + 2048);
    { const int ii = tid >> 3, q = tid & 7; w3s[tid] = p.in[25][(size_t)l * 64 * 1024 + ii * 1024 + (q >> 2) * 512 + o * 256 + cg4 * 4 + (q & 3)]; }
    __syncthreads();
    float b3v[8], del[4], asum[4];
#pragma unroll
    for (int q = 0; q < 8; ++q) b3v[q] = p.in[26][l * 1024 + (q >> 2) * 512 + o * 256 + cg4 * 4 + (q & 3)];
#pragma unroll
    for (int cc = 0; cc < 4; ++cc) { del[cc] = fabsf(p.in[28][l * 512 + o * 256 + cg4 * 4 + cc]); asum[cc] = 0.f; }
    const float* H = (const float*)(p.ws + WS_H2) + ((size_t)l * 4352 + (Lsel ? 256 : 0)) * 64;
    bf16_t* Gb = filt_ptr(p, l, Lsel) + (size_t)(o * 256 + cg4 * 4) * (2 * L);
#pragma unroll 1
    for (int t = tid; t < L; t += NTHR) {
        const float* hp = H + (size_t)t * 64;
        f32x4 a0 = (f32x4){0.f, 0.f, 0.f, 0.f}, a1 = a0;
        f32x4 cur = *(const f32x4*)hp;
#pragma unroll 1
        for (int i = 0; i < 16; ++i) {
            const f32x4 nxt = *(const f32x4*)(hp + ((i + 1) & 15) * 4);
            const LAS float* wp = w3s + i * 32;
#pragma unroll
            for (int j = 0; j < 4; ++j) { const f32x4 wa = *(const LAS f32x4*)(wp + j * 8), wb = *(const LAS f32x4*)(wp + j * 8 + 4); a0 += cur[j] * wa; a1 += cur[j] * wb; }
            cur = nxt;
        }
        const float tl = (float)t / (float)(L - 1);
#pragma unroll
        for (int cc = 0; cc < 4; ++cc) { const float dec = expf(-tl * del[cc]) + 0.05f; const float kf = (a0[cc] + b3v[cc]) * dec, kb = (a1[cc] + b3v[4 + cc]) * dec;
            Gb[(size_t)cc * 2 * L + (L - t)] = f2bf(kf); asum[cc] += fabsf(kf);
            if (t >= 1) { Gb[(size_t)cc * 2 * L + L + t] = f2bf(kb); asum[cc] += fabsf(kb); } }
    }
    if (tid < 4) Gb[(size_t)tid * 2 * L] = 0;
#pragma unroll
    for (int cc = 0; cc < 4; ++cc) { float v = asum[cc];
#pragma unroll
        for (int off = 32; off >= 1; off >>= 1) v += __shfl_xor(v, off);
        if (lane == 0) red[wave * 4 + cc] = v; }
    __syncthreads();
    if (tid < 4) { float s = 0.f;
#pragma unroll
        for (int w = 0; w < 8; ++w) s += red[w * 4 + tid];
        ((float*)(p.ws + WS_FSC))[((l * 2 + Lsel) * 2 + o) * 256 + cg4 * 4 + tid] = 1.0f / (s + 1e-6f); }
    __syncthreads();
}

__device__ void ph_norm(const Params& p, int l, int ni, const float* xp, const float* xs) {
    const int tid = otid(), lane = tid & 63, wave = tid >> 6;
    const float* nw = p.in[8] + (l * 3 + ni) * 1024; const float* mod = (const float*)(p.ws + WS_MOD) + (size_t)l * 5 * 9216;
    bf16_t* ab = (bf16_t*)(p.ws + WS_ABUF);
    for (int row = blockIdx.x * 8 + wave; row < MTOK; row += gridDim.x * 8) {
        const float* src = row < MPR ? xp + (size_t)row * 1024 : xs + (size_t)(row - MPR) * 1024; const int ci = row < MPR ? 0 : 1 + ((row - MPR) >> 12);
        f32x4 v[4]; float ss = 0.f;
#pragma unroll
        for (int i = 0; i < 4; ++i) { v[i] = *(const f32x4*)(src + i * 256 + lane * 4); ss += v[i][0] * v[i][0] + v[i][1] * v[i][1] + v[i][2] * v[i][2] + v[i][3] * v[i][3]; }
#pragma unroll
        for (int off = 32; off >= 1; off >>= 1) ss += __shfl_xor(ss, off);
        const float rstd = rsqrtf(ss * (1.0f / 1024.0f) + 1e-6f);
        const float* msh = mod + (size_t)ci * 9216 + (3 * ni) * 1024; const float* msc = msh + 1024;
#pragma unroll
        for (int i = 0; i < 4; ++i) { const int col = i * 256 + lane * 4; const f32x4 g = *(const f32x4*)(nw + col), sc = *(const f32x4*)(msc + col), sh = *(const f32x4*)(msh + col);
            const f32x4 y = v[i] * rstd * g * (1.0f + sc) + sh; u32x2 w; w.x = pk(y[0], y[1]); w.y = pk(y[2], y[3]);
            *(u32x2*)(ab + (size_t)row * 1024 + col) = w; }
    }
}

struct EpiSwiglu {
    static constexpr bool PERM = false, AFTER_DRAIN = false;
    bf16_t* act;
    __device__ __forceinline__ void operator()(const f32x4 (&acc)[2][2][4][2], const pg8::Unit& u, int wr, int wc, int fr, int fq) const {
        const int row0 = u.pm * 256 + wr * 64 + fr, col0 = u.pn * 128 + wc * 16 + 4 * fq;
#pragma unroll
        for (int ai = 0; ai < 2; ++ai)
#pragma unroll
            for (int m = 0; m < 4; ++m) { bf16_t* rowp = act + (size_t)(row0 + ai * 128 + m * 16) * 2816 + col0;
#pragma unroll
                for (int bj = 0; bj < 2; ++bj) { const f32x4 g = acc[ai][bj][m][0], uu = acc[ai][bj][m][1]; float o[4];
#pragma unroll
                    for (int j = 0; j < 4; ++j) o[j] = g[j] / (1.0f + __expf(-g[j])) * uu[j];
                    u32x2 w; w.x = pk(o[0], o[1]); w.y = pk(o[2], o[3]); *(u32x2*)(rowp + bj * 64) = w; } }
    }
};
struct EpiResid {
    static constexpr bool PERM = false, AFTER_DRAIN = false;
    const float* xp; const float* xs; float* out; const float* gate; float coef;
    __device__ __forceinline__ void operator()(const f32x4 (&acc)[2][2][4][2], const pg8::Unit& u, int wr, int wc, int fr, int fq) const {
        const int row0 = u.pm * 256 + wr * 64 + fr, col0 = u.pn * 256 + wc * 32 + 4 * fq; const int ci = u.pm < 16 ? 0 : 1 + ((u.pm - 16) >> 4);
        const float* gp = gate + (size_t)ci * 9216 + col0; f32x4 gv[2][2];
#pragma unroll
        for (int bj = 0; bj < 2; ++bj)
#pragma unroll
            for (int n = 0; n < 2; ++n) gv[bj][n] = *(const f32x4*)(gp + bj * 128 + n * 16) * coef;
#pragma unroll
        for (int ai = 0; ai < 2; ++ai)
#pragma unroll
            for (int m = 0; m < 4; ++m) { const int r = row0 + ai * 128 + m * 16; const float* src = (r < MPR ? xp + (size_t)r * 1024 : xs + (size_t)(r - MPR) * 1024) + col0; float* dst = out + (size_t)r * 1024 + col0;
#pragma unroll
                for (int bj = 0; bj < 2; ++bj)
#pragma unroll
                    for (int n = 0; n < 2; ++n) { const f32x4 x = *(const f32x4*)(src + bj * 128 + n * 16); *(f32x4*)(dst + bj * 128 + n * 16) = x + gv[bj][n] * acc[ai][bj][m][n]; }
                asm volatile("" ::: "memory"); }
    }
};
struct EpiStore {
    static constexpr bool PERM = false, AFTER_DRAIN = false;
    bf16_t* O; int ldc;
    __device__ __forceinline__ void operator()(const f32x4 (&acc)[2][2][4][2], const pg8::Unit& u, int wr, int wc, int fr, int fq) const {
        const int row0 = u.pm * 256 + wr * 64 + fr, col0 = u.pn * 256 + wc * 32 + 4 * fq;
#pragma unroll
        for (int ai = 0; ai < 2; ++ai)
#pragma unroll
            for (int m = 0; m < 4; ++m) { bf16_t* rowp = O + (size_t)(row0 + ai * 128 + m * 16) * ldc + col0;
#pragma unroll
                for (int bj = 0; bj < 2; ++bj)
#pragma unroll
                    for (int n = 0; n < 2; ++n) { const f32x4 v = acc[ai][bj][m][n]; u32x2 w; w.x = pk(v[0], v[1]); w.y = pk(v[2], v[3]); *(u32x2*)(rowp + bj * 128 + n * 16) = w; } }
    }
};

__device__ __forceinline__ void tile_info(int row0, int& rowbase, int& L, int& s0) {
    if (row0 < MPR) { rowbase = row0 & ~255; L = 256; s0 = row0 & 255; } else { const int r = row0 - MPR; rowbase = MPR + (r & ~4095); L = 4096; s0 = r & 4095; }
}

__device__ void pool_item(const Params& p, LAS unsigned char* lds, int l, int tile, int g) {
    const int tid = otid(); int rowbase, L, s0; tile_info(tile * 64, rowbase, L, s0);
    const bf16_t* U = (const bf16_t*)(p.ws + WS_U);
    LAS float* dl = (LAS float*)lds;
    LAS float* wl = (LAS float*)(lds + 64 * 65 * 4);
    { const float* W = p.in[14] + (size_t)(l * 4 + g) * 4096;
#pragma unroll
      for (int i = 0; i < 2; ++i) { const int e = tid + i * 512; *(LAS f32x4*)(wl + e * 4) = *(const f32x4*)(W + e * 4); } }
    { const int t = tid >> 3, cs = tid & 7, s = s0 + t, half = 1 << g;
      const int lo = max(s - half, 0), hi = min(s + half, L);
      float sum[8], x[8];
#pragma unroll
      for (int j = 0; j < 8; ++j) sum[j] = 0.f;
      for (int sp = lo; sp < hi; ++sp) { const u32x4 w = *(const u32x4*)(U + (size_t)(rowbase + sp) * 1792 + g * 64 + cs * 8); unpack8(w, x);
#pragma unroll
          for (int j = 0; j < 8; ++j) sum[j] += x[j]; }
      const u32x4 w = *(const u32x4*)(U + (size_t)(rowbase + s) * 1792 + g * 64 + cs * 8); unpack8(w, x);
      const float inv = 1.0f / (float)(hi - lo);
#pragma unroll
      for (int j = 0; j < 8; ++j) dl[t * 65 + cs * 8 + j] = sum[j] * inv - x[j]; }
    __syncthreads();
    { const int t = tid >> 3, dq = tid & 7; float o[8];
#pragma unroll
      for (int j = 0; j < 8; ++j) o[j] = 0.f;
#pragma unroll 8
      for (int c = 0; c < 64; ++c) { const float d = dl[t * 65 + c]; const f32x4 wa = *(const LAS f32x4*)(wl + c * 64 + dq * 8), wb = *(const LAS f32x4*)(wl + c * 64 + dq * 8 + 4);
#pragma unroll
          for (int j = 0; j < 4; ++j) { o[j] += d * wa[j]; o[4 + j] += d * wb[j]; } }
      const float* scl = p.in[15] + l * 256 + g * 64 + dq * 8;
#pragma unroll
      for (int j = 0; j < 8; ++j) o[j] *= scl[j];
      *(u32x4*)((bf16_t*)(p.ws + WS_ABUF) + (size_t)(tile * 64 + t) * 1024 + g * 64 + dq * 8) = pack8(o); }
    __syncthreads();
}

__device__ void qk_item(const Params& p, int l, int tile) {
    const int tid = otid(); int rowbase, L, s0; tile_info(tile * 64, rowbase, L, s0);
    const bf16_t* U = (const bf16_t*)(p.ws + WS_U); const bool lat = L == 4096;
    bf16_t* QB = (bf16_t*)(p.ws + WS_QB); bf16_t* KB = (bf16_t*)(p.ws + WS_KB);
    for (int pass = 0; pass < 10; ++pass) {
        const int idx = pass * 512 + tid, e = idx & 7, hh = (idx % 80) >> 3, t = idx / 80, row = tile * 64 + t, s = s0 + t;
        const bool isq = hh < 8; const int colbase = isq ? 256 + hh * 64 : 768 + (hh - 8) * 64;
        float x[8]; unpack8(*(const u32x4*)(U + (size_t)row * 1792 + colbase + e * 8), x);
        float ss = 0.f;
#pragma unroll
        for (int j = 0; j < 8; ++j) ss += x[j] * x[j];
        ss += __shfl_xor(ss, 1); ss += __shfl_xor(ss, 2); ss += __shfl_xor(ss, 4);
        const float rstd = rsqrtf(ss * (1.0f / 64.0f) + 1e-6f);
        const float* nw = p.in[isq ? 16 : 17] + l * 64 + e * 8;
#pragma unroll
        for (int j = 0; j < 8; ++j) x[j] = x[j] * rstd * nw[j];
        if (lat) {
            const float pos = (float)((e < 4) ? (s >> 6) : (s & 63));
#pragma unroll
            for (int j = 0; j < 8; ++j) { const float xp = __shfl_xor(x[j], 2); const int fi = (e & 1) * 8 + j;
                const float ang = pos * expf(-(float)fi * (9.210340371976184f / 16.0f)); const float cs = cosf(ang), sn = sinf(ang);
                x[j] = (e & 2) ? (x[j] * cs + xp * sn) : (x[j] * cs - xp * sn); }
        }
        const u32x4 w = pack8(x);
        if (isq) *(u32x4*)(QB + (size_t)row * 512 + hh * 64 + e * 8) = w;
        else { *(u32x4*)(KB + (size_t)row * 128 + (hh - 8) * 64 + e * 8) = w;
            if (!lat) { const int b = row >> 8, sq = row & 255; float* o = p.out + OUT_K + ((size_t)(b * 2 + l) * 256 + sq) * 128 + (hh - 8) * 64 + e * 8;
                *(f32x4*)o = (f32x4){x[0], x[1], x[2], x[3]}; *(f32x4*)(o + 4) = (f32x4){x[4], x[5], x[6], x[7]}; } }
    }
}

__device__ void chunk_item(const Params& p, LAS unsigned char* lds, int l, int tile, int ch) {
    const int tid = otid(); int rowbase, L, s0; tile_info(tile * 64, rowbase, L, s0);
    const bf16_t* U = (const bf16_t*)(p.ws + WS_U);
    LAS bf16_t* T = (LAS bf16_t*)lds;
    { const int t = tid >> 3, cs = tid & 7, s = s0 + t, row = tile * 64 + t; float v[16];
      if (ch == 0) { const int col0 = 896 + cs * 16;
          unpack8(*(const u32x4*)(U + (size_t)row * 1792 + col0), v); unpack8(*(const u32x4*)(U + (size_t)row * 1792 + col0 + 8), v + 8);
          if (L == 256) { const int b = row >> 8, sq = row & 255; float* o = p.out + OUT_V + ((size_t)(b * 2 + l) * 256 + sq) * 128 + cs * 16;
#pragma unroll
              for (int q = 0; q < 4; ++q) *(f32x4*)(o + q * 4) = (f32x4){v[q * 4], v[q * 4 + 1], v[q * 4 + 2], v[q * 4 + 3]}; } }
      else { const int cc0 = (ch - 1) * 128 + cs * 16, col0 = 1024 + cc0; float a[16], b[16], c[16];
          unpack8(*(const u32x4*)(U + (size_t)row * 1792 + col0), b); unpack8(*(const u32x4*)(U + (size_t)row * 1792 + col0 + 8), b + 8);
          if (s > 0) { unpack8(*(const u32x4*)(U + (size_t)(row - 1) * 1792 + col0), a); unpack8(*(const u32x4*)(U + (size_t)(row - 1) * 1792 + col0 + 8), a + 8); }
          else {
#pragma unroll
              for (int j = 0; j < 16; ++j) a[j] = 0.f; }
          if (s < L - 1) { unpack8(*(const u32x4*)(U + (size_t)(row + 1) * 1792 + col0), c); unpack8(*(const u32x4*)(U + (size_t)(row + 1) * 1792 + col0 + 8), c + 8); }
          else {
#pragma unroll
              for (int j = 0; j < 16; ++j) c[j] = 0.f; }
          const float* sw = p.in[19] + (size_t)l * 3 * 768 + cc0; const float* sb = p.in[20] + l * 768 + cc0;
#pragma unroll
          for (int j = 0; j < 16; ++j) v[j] = a[j] * sw[j] + b[j] * sw[768 + j] + c[j] * sw[1536 + j] + sb[j]; }
      *(LAS u32x4*)(T + t * 136 + cs * 16) = pack8(v); *(LAS u32x4*)(T + t * 136 + cs * 16 + 8) = pack8(v + 8); }
    __syncthreads();
    { const int col = tid >> 2, qd = tid & 3; bf16_t* dst;
      if (ch == 0) dst = (bf16_t*)(p.ws + WS_VT) + (size_t)rowbase * 128 + (size_t)col * L;
      else { const int cc = (ch - 1) * 128 + col, which = cc >> 8, c = cc & 255; dst = (bf16_t*)(p.ws + (which == 0 ? WS_HV : (which == 1 ? WS_X1 : WS_X2))) + (size_t)rowbase * 256 + (size_t)c * L; }
      unsigned w[8];
#pragma unroll
      for (int i = 0; i < 8; ++i) { const unsigned lo = T[(qd * 16 + 2 * i) * 136 + col], hi = T[(qd * 16 + 2 * i + 1) * 136 + col]; w[i] = lo | (hi << 16); }
      *(u32x4*)(dst + s0 + qd * 16) = (u32x4){w[0], w[1], w[2], w[3]}; *(u32x4*)(dst + s0 + qd * 16 + 8) = (u32x4){w[4], w[5], w[6], w[7]}; }
    __syncthreads();
}

__device__ void ph_mixprep(const Params& p, LAS unsigned char* lds, int l) {
    for (int it = blockIdx.x; it < 320 * 12; it += gridDim.x) { const int tile = it / 12, sub = it % 12;
        if (sub < 4) pool_item(p, lds, l, tile, sub);
        else if (sub == 4) qk_item(p, l, tile);
        else chunk_item(p, lds, l, tile, sub - 5); }
}

__device__ void attn_item(const Params& p, LAS unsigned char* lds, int l, bool lat, int b, int nb, int half, int kvh) {
    const int tid = otid(), lane = tid & 63, wave = tid >> 6, r = lane & 31, h = lane >> 5;
    const int gq = wave >> 1, hq = kvh * 4 + gq;
    const int L = lat ? 4096 : 256, rowbase = lat ? MPR + b * 4096 : b * 256;
    const bf16_t* QB = (const bf16_t*)(p.ws + WS_QB); const bf16_t* KB = (const bf16_t*)(p.ws + WS_KB); const bf16_t* VT = (const bf16_t*)(p.ws + WS_VT);
    int klo = 0, nt1 = 0; const bf16_t *K1 = KB, *V1 = VT, *K2, *V2;
    if (lat) { klo = max(0, (nb - 1) * 128); const int khi = min(L, (nb + 2) * 128); nt1 = (khi - klo) >> 6;
        K1 = KB + (size_t)(rowbase + klo) * 128 + kvh * 64; V1 = VT + (size_t)rowbase * 128 + (size_t)(kvh * 64) * L + klo;
        K2 = (const bf16_t*)(p.ws + WS_KC) + (size_t)((l * 4 + b) * 256) * 128 + kvh * 64; V2 = (const bf16_t*)(p.ws + WS_VCT) + (size_t)((l * 4 + b) * 128 + kvh * 64) * 256; }
    else { K2 = KB + (size_t)rowbase * 128 + kvh * 64; V2 = VT + (size_t)rowbase * 128 + (size_t)(kvh * 64) * 256; }
    LAS bf16_t* Ks = (LAS bf16_t*)lds;
    LAS bf16_t* Vs = (LAS bf16_t*)(lds + 64 * 72 * 2);
    const int qoff = nb * 128 + half * 64 + (wave & 1) * 32; const int qrow0 = rowbase + qoff;
    bf16x8 Q[4];
#pragma unroll
    for (int ks = 0; ks < 4; ++ks) Q[ks] = *(const bf16x8*)(QB + (size_t)(qrow0 + r) * 512 + hq * 64 + 16 * ks + 8 * h);
    f32x16 O[2];
#pragma unroll
    for (int a = 0; a < 2; ++a)
#pragma unroll
        for (int q = 0; q < 16; ++q) O[a][q] = 0.f;
    const float sinkv = p.in[18][l * 8 + hq];
    float mrun = sinkv, lsum = h == 0 ? 1.f : 0.f;
    const int ldrow = tid >> 3, ldseg = tid & 7;
    for (int ti = 0; ti < nt1 + 4; ++ti) {
        const bool masked = ti < nt1; const bf16_t *Kp, *Vp; int vs, kpos0 = 0;
        if (masked) { Kp = K1 + (size_t)ti * 64 * 128; Vp = V1 + ti * 64; vs = L; kpos0 = klo + ti * 64; } else { const int j = ti - nt1; Kp = K2 + (size_t)j * 64 * 128; Vp = V2 + j * 64; vs = 256; }
        const u32x4 kreg = *(const u32x4*)(Kp + (size_t)ldrow * 128 + ldseg * 8), vreg = *(const u32x4*)(Vp + (size_t)ldrow * vs + ldseg * 8);
        __syncthreads();
        *(LAS u32x4*)(Ks + ldrow * 72 + ldseg * 8) = kreg; *(LAS u32x4*)(Vs + ldrow * 72 + ldseg * 8) = vreg;
        __syncthreads();
        {
            f32x16 S[2];
#pragma unroll
            for (int kb2 = 0; kb2 < 2; ++kb2) {
#pragma unroll
                for (int q = 0; q < 16; ++q) S[kb2][q] = 0.f;
#pragma unroll
                for (int ks = 0; ks < 4; ++ks) { const bf16x8 kf = *(const LAS bf16x8*)(Ks + (32 * kb2 + r) * 72 + 16 * ks + 8 * h);
                    S[kb2] = __builtin_amdgcn_mfma_f32_32x32x16_bf16(kf, Q[ks], S[kb2], 0, 0, 0); } }
            const int qpos = qoff + r;
            float mx = -3.0e38f;
#pragma unroll
            for (int kb2 = 0; kb2 < 2; ++kb2)
#pragma unroll
                for (int q = 0; q < 16; ++q) { float sv = S[kb2][q] * 0.125f;
                    if (masked) { const int kpos = kpos0 + 32 * kb2 + (q & 3) + 8 * (q >> 2) + 4 * h; const int df = kpos - qpos; if (df > 128 || df < -128) sv = -1.0e30f; }
                    S[kb2][q] = sv; mx = fmaxf(mx, sv); }
            mx = fmaxf(mx, __shfl_xor(mx, 32));
            const float mnew = fmaxf(mrun, mx), alpha = __expf(mrun - mnew); mrun = mnew;
            float psum = 0.f;
#pragma unroll
            for (int kb2 = 0; kb2 < 2; ++kb2)
#pragma unroll
                for (int q = 0; q < 16; ++q) { const float pv = __expf(S[kb2][q] - mnew); S[kb2][q] = pv; psum += pv; }
            lsum = lsum * alpha + psum;
#pragma unroll
            for (int db = 0; db < 2; ++db)
#pragma unroll
                for (int q = 0; q < 16; ++q) O[db][q] *= alpha;
#pragma unroll
            for (int kb2 = 0; kb2 < 2; ++kb2)
#pragma unroll
                for (int s = 0; s < 2; ++s) { u32x4 pw; pw.x = pk(S[kb2][8 * s], S[kb2][8 * s + 1]); pw.y = pk(S[kb2][8 * s + 2], S[kb2][8 * s + 3]); pw.z = pk(S[kb2][8 * s + 4], S[kb2][8 * s + 5]); pw.w = pk(S[kb2][8 * s + 6], S[kb2][8 * s + 7]);
                    const bf16x8 pf = __builtin_bit_cast(bf16x8, pw);
#pragma unroll
                    for (int db = 0; db < 2; ++db) { const LAS bf16_t* vp = Vs + (32 * db + r) * 72 + 32 * kb2 + 16 * s + 4 * h;
                        const u32x2 v0 = *(const LAS u32x2*)vp, v1 = *(const LAS u32x2*)(vp + 8); const u32x4 vw = (u32x4){v0.x, v0.y, v1.x, v1.y};
                        O[db] = __builtin_amdgcn_mfma_f32_32x32x16_bf16(__builtin_bit_cast(bf16x8, vw), pf, O[db], 0, 0, 0); } }
        }
    }
    bf16_t* MX = (bf16_t*)(p.ws + WS_ABUF);
    { const float lt = lsum + __shfl_xor(lsum, 32); const float inv = 1.0f / lt;
        bf16_t* orow = MX + (size_t)(qrow0 + r) * 1024 + 256 + hq * 64;
#pragma unroll
        for (int db = 0; db < 2; ++db)
#pragma unroll
            for (int g4 = 0; g4 < 4; ++g4) { u32x2 w; w.x = pk(O[db][4 * g4] * inv, O[db][4 * g4 + 1] * inv); w.y = pk(O[db][4 * g4 + 2] * inv, O[db][4 * g4 + 3] * inv);
                *(u32x2*)(orow + 32 * db + 8 * g4 + 4 * h) = w; } }
    __syncthreads();
}

__device__ void conv_item(const Params& p, LAS unsigned char* lds, int l, bool smp, int c, int order) {
    const int tid = otid(), lane = tid & 63, wave = tid >> 6, r = lane & 31, h = lane >> 5;
    const int L = smp ? 4096 : 256, NB = smp ? 4 : 16, rowbase0 = smp ? MPR : 0, Lsel = smp ? 1 : 0;
    const int nblk = L >> 5, Iper = 32 / NB, npairs = nblk / (2 * Iper);
    constexpr int PADE = 480;
    const int zstride = L + 2 * PADE;
    LAS bf16_t* zs = (LAS bf16_t*)lds;
    LAS bf16_t* fl = (LAS bf16_t*)(lds + (size_t)NB * zstride * 2);
    const bf16_t* zin = (const bf16_t*)(p.ws + (order == 0 ? WS_HV : WS_Z1));
    const bf16_t* gate = (const bf16_t*)(p.ws + (order == 0 ? WS_X1 : WS_X2));
    const bf16_t* filt = filt_ptr(p, l, Lsel) + (size_t)(order * 256 + c) * (2 * L);
    const float fs = ((const float*)(p.ws + WS_FSC))[((l * 2 + Lsel) * 2 + order) * 256 + c];
    const float bd = p.in[29][l * 512 + order * 256 + c];
    const int nch = L >> 3;
    for (int i = tid; i < NB * nch; i += NTHR) { const int b = i / nch, ch = i % nch;
        *(LAS u32x4*)(zs + b * zstride + PADE + ch * 8) = *(const u32x4*)(zin + (size_t)(rowbase0 + b * L) * 256 + (size_t)c * L + ch * 8); }
    for (int i = tid; i < NB * 120; i += NTHR) { const int b = i / 120, q = i % 120; const int off = q < 60 ? q * 8 : PADE + L + (q - 60) * 8;
        *(LAS u32x4*)(zs + b * zstride + off) = (u32x4){0u, 0u, 0u, 0u}; }
    for (int i = tid; i < (2 * L) / 8; i += NTHR) *(LAS u32x4*)(fl + i * 8) = *(const u32x4*)(filt + i * 8);
    __syncthreads();
    const int bcol = r % NB, Iloc = r / NB;
    for (int gp = wave; gp < npairs; gp += 8) {
        const int I0a = 2 * gp * Iper, I0b = I0a + Iper;
        f32x16 acc[2];
#pragma unroll
        for (int q = 0; q < 16; ++q) { acc[0][q] = 0.f; acc[1][q] = 0.f; }
        const int Dlo = I0a - (nblk - 1), Dhi = I0b + Iper - 1;
        const LAS bf16_t* zb = zs + bcol * zstride + PADE + 8 * h;
        for (int D = Dlo; D <= Dhi; ++D) {
            const int st = L - 32 * D - r + 8 * h;
            bf16x8 af[2];
#pragma unroll
            for (int ks = 0; ks < 2; ++ks)
#pragma unroll
                for (int j = 0; j < 8; ++j) af[ks][j] = (short)fl[st + 16 * ks + j];
#pragma unroll
            for (int x = 0; x < 2; ++x) { const int J = (x ? I0b : I0a) + Iloc - D;
#pragma unroll
                for (int ks = 0; ks < 2; ++ks) { const bf16x8 bfr = *(const LAS bf16x8*)(zb + 32 * J + 16 * ks);
                    acc[x] = __builtin_amdgcn_mfma_f32_32x32x16_bf16(af[ks], bfr, acc[x], 0, 0, 0); } }
        }
#pragma unroll
        for (int x = 0; x < 2; ++x) { const int I = (x ? I0b : I0a) + Iloc; const int rb = rowbase0 + bcol * L;
#pragma unroll
            for (int g4 = 0; g4 < 4; ++g4) { const int t0 = 32 * I + 8 * g4 + 4 * h;
                const u32x2 zc = *(const LAS u32x2*)(zs + bcol * zstride + PADE + t0);
                const size_t gi = (size_t)rb * 256 + (size_t)c * L + t0;
                const u32x2 gw = *(const u32x2*)(gate + gi);
                float o[4];
                o[0] = bflo(gw.x) * (acc[x][4 * g4] * fs + bd * bflo(zc.x)); o[1] = bfhi(gw.x) * (acc[x][4 * g4 + 1] * fs + bd * bfhi(zc.x));
                o[2] = bflo(gw.y) * (acc[x][4 * g4 + 2] * fs + bd * bflo(zc.y)); o[3] = bfhi(gw.y) * (acc[x][4 * g4 + 3] * fs + bd * bfhi(zc.y));
                if (order == 0) { u32x2 w; w.x = pk(o[0], o[1]); w.y = pk(o[2], o[3]); *(u32x2*)((bf16_t*)(p.ws + WS_Z1) + gi) = w; }
                else { bf16_t* mp = (bf16_t*)(p.ws + WS_ABUF) + (size_t)(rb + t0) * 1024 + 768 + c;
#pragma unroll
                    for (int j = 0; j < 4; ++j) mp[(size_t)j * 1024] = f2bf(o[j]); } } }
    }
    __syncthreads();
}

__device__ void ph_attn_conv1(const Params& p, LAS unsigned char* lds, int l) {
    for (int it = blockIdx.x; it < 1152; it += gridDim.x) {
        if (it < 256) conv_item(p, lds, l, true, it, 0);
        else if (it < 768) { const int a = it - 256; attn_item(p, lds, l, true, a >> 7, (a >> 2) & 31, (a >> 1) & 1, a & 1); }
        else if (it < 1024) conv_item(p, lds, l, false, it - 768, 0);
        else { const int a = it - 1024; attn_item(p, lds, l, false, a >> 3, (a >> 2) & 1, (a >> 1) & 1, a & 1); }
    }
}
__device__ void ph_conv2(const Params& p, LAS unsigned char* lds, int l) {
    for (int it = blockIdx.x; it < 512; it += gridDim.x) conv_item(p, lds, l, it < 256, it & 255, 1);
}

#ifndef PH_MASK
#define PH_MASK 0xffff
#endif
#define EN(x) (((PH_MASK) >> (x)) & 1)
template <class Epi>
__device__ __forceinline__ void run_gemm(LAS unsigned char* lds, const bf16_t* A, const bf16_t* Bt, int N, int K, const Epi& E) {
    pg8::Gemm g{A, Bt, MTOK, N, K}; pg8::StaticOrder S; S.init(MTOK, N, (int)gridDim.x, (int)blockIdx.x);
    pg8::gemm_phase<Epi, pg8::StaticOrder>(lds, g, S, E);
}

__global__ void __launch_bounds__(NTHR) mega(Params p) {
    extern __shared__ __attribute__((aligned(16))) unsigned char smem[];
    LAS unsigned char* lds = (LAS unsigned char*)smem;
    cg::grid_group grid = cg::this_grid();
    float* X = p.out; const float* mod = (const float*)(p.ws + WS_MOD);
    bf16_t* AB = (bf16_t*)(p.ws + WS_ABUF);
    for (int ph = p.ph_lo; ph < p.ph_hi; ++ph) {
        if (ph == 0) { if (EN(0)) ph_prep(p, lds); }
        else {
            const int l = (ph - 1) / 12, s = (ph - 1) % 12;
            const float* xp = (l == 0 && s < 3) ? p.in[0] : X; const float* xs = (l == 0 && s < 3) ? p.in[1] : X + (size_t)MPR * 1024;
            const float* ml = mod + (size_t)l * 5 * 9216;
            switch (s) {
            case 0: if (EN(1)) { if (l == 0) { for (int it = blockIdx.x; it < 512; it += gridDim.x) filter_item(p, lds, it); } }
                    if (EN(2)) ph_norm(p, l, 0, xp, xs); break;
            case 1: if (EN(3)) run_gemm(lds, AB, (const bf16_t*)(p.ws + WS_WGU + (size_t)(l * 2) * SZ_WGU), 5632, 1024, EpiSwiglu{(bf16_t*)(p.ws + WS_ACT)}); break;
            case 2: if (EN(4)) run_gemm(lds, (const bf16_t*)(p.ws + WS_ACT), (const bf16_t*)(p.ws + WS_WD + (size_t)(l * 2) * SZ_WD), 1024, 2816, EpiResid{xp, xs, X, ml + 2 * 1024, 0.5f}); break;
            case 3: if (EN(2)) ph_norm(p, l, 1, X, X + (size_t)MPR * 1024); break;
            case 4: if (EN(5)) run_gemm(lds, AB, (const bf16_t*)(p.ws + WS_WIN + (size_t)l * SZ_WIN), 1792, 1024, EpiStore{(bf16_t*)(p.ws + WS_U), 1792}); break;
            case 5: if (EN(6)) ph_mixprep(p, lds, l); break;
            case 6: if (EN(7)) ph_attn_conv1(p, lds, l); break;
            case 7: if (EN(8)) ph_conv2(p, lds, l); break;
            case 8: if (EN(4)) run_gemm(lds, AB, (const bf16_t*)(p.ws + WS_WOUT + (size_t)l * SZ_WOUT), 1024, 1024, EpiResid{X, X + (size_t)MPR * 1024, X, ml + 5 * 1024, 1.0f}); break;
            case 9: if (EN(2)) ph_norm(p, l, 2, X, X + (size_t)MPR * 1024); break;
            case 10: if (EN(3)) run_gemm(lds, AB, (const bf16_t*)(p.ws + WS_WGU + (size_t)(l * 2 + 1) * SZ_WGU), 5632, 1024, EpiSwiglu{(bf16_t*)(p.ws + WS_ACT)}); break;
            default: if (EN(4)) run_gemm(lds, (const bf16_t*)(p.ws + WS_ACT), (const bf16_t*)(p.ws + WS_WD + (size_t)(l * 2 + 1) * SZ_WD), 1024, 2816, EpiResid{X, X + (size_t)MPR * 1024, X, ml + 8 * 1024, 0.5f}); break;
            }
        }
        if (ph + 1 < p.ph_hi) grid.sync();
    }
}

#ifndef MK_MULTI
#define MK_MULTI 0
#endif
extern "C" void kernel_launch(void* const* d_in, const int* in_sizes, int n_in, void* d_out, int out_size, void* d_ws, size_t ws_size, hipStream_t stream) {
    static int grid = 0;
    if (grid == 0) {
        if (n_in != 30 || ws_size < WS_END) { fprintf(stderr, "kernel_launch: bad arguments: n_in %d ws %zu (need %zu)\n", n_in, ws_size, (size_t)WS_END); grid = -1; return; }
        int dev = 0, cus = 0, per_cu = 0;
        hipGetDevice(&dev); hipDeviceGetAttribute(&cus, hipDeviceAttributeMultiprocessorCount, dev);
        if (hipFuncSetAttribute((const void*)mega, hipFuncAttributeMaxDynamicSharedMemorySize, LDS_BYTES) != hipSuccess) { fprintf(stderr, "kernel_launch: hipFuncSetAttribute failed\n"); grid = -1; return; }
        if (hipOccupancyMaxActiveBlocksPerMultiprocessor(&per_cu, (const void*)mega, NTHR, LDS_BYTES) != hipSuccess || per_cu < 1) { fprintf(stderr, "kernel_launch: occupancy query says %d\n", per_cu); per_cu = 1; }
        (void)hipGetLastError();
        grid = cus * 1;
    }
    if (grid < 0) return;
    Params prm{};
    for (int i = 0; i < 30; ++i) prm.in[i] = (const float*)d_in[i];
    prm.out = (float*)d_out; prm.ws = (unsigned char*)d_ws;
#if MK_MULTI
    for (int ph = 0; ph < NPH; ++ph) { prm.ph_lo = ph; prm.ph_hi = ph + 1; hipLaunchKernelGGL(mega, dim3(grid), dim3(NTHR), LDS_BYTES, stream, prm); }
#else
    prm.ph_lo = 0; prm.ph_hi = NPH;
    void* args[] = {&prm};
    hipError_t e = hipLaunchCooperativeKernel((const void*)mega, dim3(grid), dim3(NTHR), args, LDS_BYTES, stream);
    if (e != hipSuccess) fprintf(stderr, "cooperative launch failed: %s (grid %d)\n", hipGetErrorString(e), grid);
#endif
}
```

```cpp
#include <hip/hip_runtime.h>
#include <hip/hip_cooperative_groups.h>
#include <cstdio>
namespace cg = cooperative_groups;
namespace pg8 {
#define PG8_LAS __attribute__((address_space(3)))
typedef unsigned short bf16_t;
typedef short bf16x8 __attribute__((ext_vector_type(8)));
typedef float f32x4 __attribute__((ext_vector_type(4)));
typedef unsigned u32x4 __attribute__((ext_vector_type(4)));
constexpr int BM = 256, BK = 64, HALF = 128, HTB = HALF * BK * 2  , STAGE_BYTES = 8 * HTB, NXCD = 8, WGM = 8;
__host__ __device__ __forceinline__ int lds_byte(int r, int c) { const int st = (r >> 4) * 2 + (c >> 5), rr = r & 15, cc = c & 31, ob = rr * 64 + cc * 2; return st * 1024 + (ob ^ (((ob >> 9) & 1) << 5)); }
__host__ __device__ __forceinline__ void stage_rc(int b, int& R, int& C) { const int st = b / 1024, sb = b % 1024, swz = sb ^ (((sb >> 9) & 1) << 5); R = (st >> 1) * 16 + swz / 64; C = (st & 1) * 32 + (swz % 64) / 2; }
__host__ __device__ __forceinline__ int perm32(int rho) { const int n = rho >> 4, i = rho & 15; return 8 * (i >> 2) + 4 * n + (i & 3); }

struct Unit { int pm, pn; };
struct Gemm { const bf16_t* A; const bf16_t* Bt; int M, N, K; };
struct StaticOrder {
    int nM, nN, nwg, G, c;
    __host__ __device__ void init(int M, int N, int G_, int c_) { nM = M / BM; nN = N / BM; nwg = nM * nN; G = G_; c = c_; }
    __host__ __device__ bool next(int i, Unit& u) const {
        const long L = (long)i * G + c; if (L >= nwg) return false;
        int wgid = (int)L; { const int q = nwg / NXCD, r = nwg % NXCD, xcd = wgid % NXCD, off = wgid / NXCD; wgid = (xcd < r ? xcd * (q + 1) : r * (q + 1) + (xcd - r) * q) + off; }
        const int nig = WGM * nN, gid = wgid / nig, fm = gid * WGM, gsz = (nM - fm) < WGM ? (nM - fm) : WGM;
        u.pm = fm + ((wgid % nig) % gsz); u.pn = (wgid % nig) / gsz; return true;
    }
    __device__ __forceinline__ void a_ready(const Unit&) const {}
    __device__ __forceinline__ void done(const Unit&) const {}
};
__device__ __forceinline__ unsigned cvt_pk_bf16(float lo, float hi) { unsigned r; asm volatile("v_cvt_pk_bf16_f32 %0, %1, %2" : "=v"(r) : "v"(lo), "v"(hi)); return r; }
template <class Epi, class Sched>
__device__ __forceinline__ void gemm_phase(PG8_LAS unsigned char* lds, const Gemm g, const Sched& S, const Epi& E) {
    int tid_ = threadIdx.x; asm volatile("" : "+v"(tid_)); const int tid = tid_, wid = __builtin_amdgcn_readfirstlane(tid >> 6), lane = tid & 63, wr = wid >> 2, wc = wid & 3, fr = lane & 15, fq = lane >> 4;
    const int K = g.K, nt = K / BK;
#define PG8_STAMP() do {} while (0)
    unsigned voffA[2], voffB[2];
#pragma unroll
    for (int i = 0; i < 2; ++i) { int R, C; stage_rc(tid * 16 + i * 8192, R, C); const int Rb = Epi::PERM ? ((R & ~31) + perm32(R & 31)) : R;
        voffA[i] = (unsigned)(R * K + C) * 2u; voffB[i] = (unsigned)(Rb * K + C) * 2u; }
    const size_t kstep = (size_t)(BK * 2);
    const size_t hstep = (size_t)HALF * K * 2;
    const size_t tstep = 2 * hstep;
    const unsigned ldsw = (unsigned)wid * 1024u;
    const int aoff = lds_byte(wr * 64 + fr, fq * 8), boff = lds_byte(wc * 32 + fr, fq * 8);
#define PG8_SA(b, h) (((b) * 2 + (h)) * HTB)
#define PG8_SB(b, h) ((4 + (b) * 2 + (h)) * HTB)
#define PG8_STAGE(bufoff, gbase, voff) do { _Pragma("unroll") for (int _i = 0; _i < 2; ++_i) \
        __builtin_amdgcn_global_load_lds((const unsigned*)((const char*)(gbase) + (voff)[_i]), (PG8_LAS unsigned*)(lds + (bufoff) + ldsw + _i * 8192), 16, 0, 0); } while (0)
#define PG8_LDA(dst, b, h) do { _Pragma("unroll") for (int m = 0; m < 4; ++m) _Pragma("unroll") for (int k = 0; k < 2; ++k) dst[m][k] = *(const PG8_LAS bf16x8*)(lds + PG8_SA(b, h) + aoff + m * 2048 + k * 1024); } while (0)
#define PG8_LDB(dst, b, h) do { _Pragma("unroll") for (int n = 0; n < 2; ++n) _Pragma("unroll") for (int k = 0; k < 2; ++k) dst[n][k] = *(const PG8_LAS bf16x8*)(lds + PG8_SB(b, h) + boff + n * 2048 + k * 1024); } while (0)
#define PG8_MMA(ai, bj, At, Bt) do { __builtin_amdgcn_s_setprio(1); _Pragma("unroll") for (int m = 0; m < 4; ++m) _Pragma("unroll") for (int n = 0; n < 2; ++n) _Pragma("unroll") for (int k = 0; k < 2; ++k) \
        acc[ai][bj][m][n] = __builtin_amdgcn_mfma_f32_16x16x32_bf16(Bt[n][k], At[m][k], acc[ai][bj][m][n], 0, 0, 0); __builtin_amdgcn_s_setprio(0); } while (0)
#define PG8_WAIT_V(n) asm volatile("s_waitcnt vmcnt(" #n ")" ::: "memory")
#define PG8_WAIT_L(n) asm volatile("s_waitcnt lgkmcnt(" #n ")" ::: "memory")
#define PG8_BAR __builtin_amdgcn_s_barrier()
#define PG8_SCHED __builtin_amdgcn_sched_barrier(0)
    Unit cur, nxt; int ui = 0;
    if (!S.next(0, cur)) return;
    f32x4 acc[2][2][4][2];
#pragma unroll
    for (int a = 0; a < 2; ++a)
#pragma unroll
        for (int b = 0; b < 2; ++b)
#pragma unroll
            for (int m = 0; m < 4; ++m)
#pragma unroll
                for (int n = 0; n < 2; ++n) acc[a][b][m][n] = (f32x4){0.f, 0.f, 0.f, 0.f};
    bf16x8 At[4][2], B0[2][2], B1[2][2];
    const char* cA = (const char*)g.A + (size_t)cur.pm * tstep; const char* cB = (const char*)g.Bt + (size_t)cur.pn * tstep;
    S.a_ready(cur);
    PG8_STAGE(PG8_SB(0, 0), cB, voffB); PG8_STAGE(PG8_SA(0, 0), cA, voffA); PG8_STAGE(PG8_SB(0, 1), cB + hstep, voffB); PG8_STAGE(PG8_SA(0, 1), cA + hstep, voffA);
    if (wr == 1) PG8_BAR;
    PG8_WAIT_V(4); PG8_BAR;
    PG8_STAGE(PG8_SB(1, 0), cB + kstep, voffB); PG8_STAGE(PG8_SA(1, 0), cA + kstep, voffA); PG8_STAGE(PG8_SB(1, 1), cB + hstep + kstep, voffB);
    PG8_WAIT_V(6); PG8_BAR;
    PG8_STAMP();
    for (;;) {
        const bool has_next = S.next(ui + 1, nxt);
        const char* nA = has_next ? (const char*)g.A + (size_t)nxt.pm * tstep : cA; const char* nB = has_next ? (const char*)g.Bt + (size_t)nxt.pn * tstep : cB;
        for (int t = 0; t < nt; t += 2) {
            const bool last = (t == nt - 2);
            const char* a1 = cA + (size_t)(t + 1) * kstep;
            const char* a2 = last ? nA : cA + (size_t)(t + 2) * kstep; const char* b2 = last ? nB : cB + (size_t)(t + 2) * kstep;
            const char* a3 = a2 + kstep; const char* b3 = b2 + kstep;
            if (last && has_next) S.a_ready(nxt);
            PG8_LDB(B0, 0, 0); PG8_SCHED; PG8_LDA(At, 0, 0); PG8_STAGE(PG8_SA(1, 1), a1 + hstep, voffA);
            PG8_WAIT_L(8); PG8_BAR; PG8_WAIT_L(0); PG8_MMA(0, 0, At, B0); PG8_BAR; PG8_SCHED;
            PG8_LDB(B1, 0, 1); PG8_STAGE(PG8_SB(0, 0), b2, voffB);
            PG8_BAR; PG8_WAIT_L(0); PG8_MMA(0, 1, At, B1); PG8_BAR;
            PG8_LDA(At, 0, 1); PG8_STAGE(PG8_SA(0, 0), a2, voffA);
            PG8_BAR; PG8_WAIT_L(0); PG8_MMA(1, 0, At, B0); PG8_BAR; PG8_SCHED;
            PG8_STAGE(PG8_SB(0, 1), b2 + hstep, voffB);
            PG8_WAIT_V(6); PG8_BAR; PG8_MMA(1, 1, At, B1); PG8_BAR;
            PG8_LDB(B0, 1, 0); PG8_SCHED; PG8_LDA(At, 1, 0); PG8_STAGE(PG8_SA(0, 1), a2 + hstep, voffA);
            PG8_WAIT_L(8); PG8_BAR; PG8_WAIT_L(0); PG8_MMA(0, 0, At, B0); PG8_BAR; PG8_SCHED;
            PG8_LDB(B1, 1, 1); PG8_STAGE(PG8_SB(1, 0), b3, voffB);
            PG8_BAR; PG8_WAIT_L(0); PG8_MMA(0, 1, At, B1); PG8_BAR;
            PG8_LDA(At, 1, 1); PG8_STAGE(PG8_SA(1, 0), a3, voffA);
            PG8_BAR; PG8_WAIT_L(0); PG8_MMA(1, 0, At, B0); PG8_BAR; PG8_SCHED;
            PG8_STAGE(PG8_SB(1, 1), b3 + hstep, voffB);
            PG8_WAIT_V(6); PG8_BAR; PG8_MMA(1, 1, At, B1); PG8_BAR;
        }
        PG8_STAMP();
        if constexpr (!Epi::AFTER_DRAIN) { E(acc, cur, wr, wc, fr, fq); S.done(cur); }
        PG8_STAMP();
        if (!has_next) break;
#pragma unroll
        for (int a = 0; a < 2; ++a)
#pragma unroll
            for (int b = 0; b < 2; ++b)
#pragma unroll
                for (int m = 0; m < 4; ++m)
#pragma unroll
                    for (int n = 0; n < 2; ++n) acc[a][b][m][n] = (f32x4){0.f, 0.f, 0.f, 0.f};
        cur = nxt; cA = nA; cB = nB; ++ui;
    }
    PG8_WAIT_V(0);
    if (wr == 0) PG8_BAR;
    PG8_BAR;
    if constexpr (Epi::AFTER_DRAIN) { E.fused(acc, cur, wr, wc, fr, fq, lds, wid, lane); S.done(cur); }
    PG8_STAMP();
#undef PG8_SA
#undef PG8_SB
#undef PG8_STAGE
#undef PG8_LDA
#undef PG8_LDB
#undef PG8_MMA
#undef PG8_WAIT_V
#undef PG8_WAIT_L
#undef PG8_BAR
#undef PG8_SCHED
}
}


#define XB_SPIN_CAP (1u << 18)

#define XB_TMO      128
#define XB_XCNT(j)  (256  + 64 * (j))
#define XB_XSUB(j)  (1280 + 64 * (j))
#define XB_XGEN(j)  (2304 + 64 * (j))
#define XB_TOP      3328
#define XB_TOPGEN   3392
#define XCD_BAR_WORDS 3456
#define LAS __attribute__((address_space(3)))

__device__ __forceinline__ unsigned xb_ld(unsigned* p)              { return __hip_atomic_load(p, __ATOMIC_RELAXED, __HIP_MEMORY_SCOPE_AGENT); }
__device__ __forceinline__ unsigned xb_add(unsigned* p, unsigned v) { return __hip_atomic_fetch_add(p, v, __ATOMIC_RELAXED, __HIP_MEMORY_SCOPE_AGENT); }
__device__ __forceinline__ unsigned xb_xcc_id() { return (unsigned)__builtin_amdgcn_s_getreg((3 << 11) | 20) & 0xFu; }
#define XB_SPIN(cond, bar) do { unsigned _sp = 0; while (cond) { __builtin_amdgcn_s_sleep(1); \
    if ((++_sp & 255u) == 0u) { if (xb_ld(&(bar)[XB_TMO])) break; if (_sp > XB_SPIN_CAP) { atomicAdd(&(bar)[XB_TMO], 1u); break; } } } } while (0)
struct XcdBarrier {
    unsigned* bar; unsigned x;
    volatile LAS unsigned* st;
};

__device__ __forceinline__ XcdBarrier xcd_barrier_post(unsigned* bar, volatile LAS unsigned* st) {
    XcdBarrier b; b.bar = bar; b.x = xb_xcc_id(); b.st = st;
    if (threadIdx.x == 0) (void)xb_add(&bar[XB_XCNT(b.x)], 1u);
    return b;
}
__device__ __forceinline__ void xcd_barrier_complete(unsigned* bar, unsigned x, unsigned& nloc, unsigned& nx) {
    const unsigned G = gridDim.x * gridDim.y * gridDim.z;
    unsigned sum, cnt, mine, sp = 0u;
    for (;;) {
        sum = 0u; cnt = 0u; mine = 0u;
#pragma unroll
        for (unsigned j = 0; j < 16; ++j) { const unsigned c = xb_ld(&bar[XB_XCNT(j)]); sum += c; cnt += (c > 0u) ? 1u : 0u; mine = (j == x) ? c : mine; }
        if (sum == G) break;
        __builtin_amdgcn_s_sleep(1);
        if ((++sp & 255u) == 0u) { if (xb_ld(&bar[XB_TMO])) break; if (sp > XB_SPIN_CAP) { atomicAdd(&bar[XB_TMO], 1u); break; } }
    }
    nloc = mine > 0u ? mine : 1u; nx = cnt > 0u ? cnt : 1u;
}

__device__ __forceinline__ void xcd_barrier(const XcdBarrier& b) {
    asm volatile("s_waitcnt vmcnt(0)" ::: "memory");
    __syncthreads();
    if (threadIdx.x == 0) {
        unsigned* bar = b.bar;
        __builtin_amdgcn_s_waitcnt(0);
        unsigned nloc = b.st[0], nx = b.st[1];
        if (nloc == 0u) { xcd_barrier_complete(bar, b.x, nloc, nx); b.st[0] = nloc; b.st[1] = nx; }
        const unsigned old = xb_add(&bar[XB_XSUB(b.x)], 1u);
        const unsigned gen = old / nloc;
        if (old + 1u == (gen + 1u) * nloc) {
            __builtin_amdgcn_fence(__ATOMIC_RELEASE, "agent");
            asm volatile("s_waitcnt vmcnt(0)" ::: "memory");
            const unsigned og = xb_add(&bar[XB_TOP], 1u);
            const unsigned tg = og / nx;
            if (og + 1u == (tg + 1u) * nx) xb_add(&bar[XB_TOPGEN], 1u);
            else XB_SPIN(xb_ld(&bar[XB_TOPGEN]) == tg, bar);
            __builtin_amdgcn_fence(__ATOMIC_ACQUIRE, "agent");
            xb_add(&bar[XB_XGEN(b.x)], 1u);
            asm volatile("s_waitcnt vmcnt(0)" ::: "memory");
        } else {
            XB_SPIN(xb_ld(&bar[XB_XGEN(b.x)]) == gen, bar);
            __builtin_amdgcn_fence(__ATOMIC_ACQUIRE, "agent");
            asm volatile("s_waitcnt vmcnt(0)" ::: "memory");
        }
    }
    __syncthreads();
}


#define LAS __attribute__((address_space(3)))
typedef unsigned short bf16_t;
typedef short bf16x8 __attribute__((ext_vector_type(8)));
typedef float f32x4 __attribute__((ext_vector_type(4)));
typedef float f32x16 __attribute__((ext_vector_type(16)));
typedef unsigned u32x4 __attribute__((ext_vector_type(4)));
typedef unsigned u32x2 __attribute__((ext_vector_type(2)));

constexpr int MTOK = 20480, MPR = 4096;
constexpr int NPH = 25;
constexpr int LDS_BYTES = 131072 + 16;
constexpr int NTHR = 512;

constexpr size_t SZ_WGU = (size_t)5632 * 1024 * 2, SZ_WD = (size_t)1024 * 2816 * 2, SZ_WIN = (size_t)1792 * 1024 * 2, SZ_WOUT = (size_t)1024 * 1024 * 2;
constexpr size_t WS_WGU = 0;
constexpr size_t WS_WD = WS_WGU + 4 * SZ_WGU;
constexpr size_t WS_WIN = WS_WD + 4 * SZ_WD;
constexpr size_t WS_WOUT = WS_WIN + 2 * SZ_WIN;
constexpr size_t WS_MOD = WS_WOUT + 2 * SZ_WOUT;
constexpr size_t WS_ABUF = WS_MOD + (size_t)2 * 5 * 9216 * 4;
constexpr size_t WS_R = WS_ABUF + (size_t)MTOK * 1024 * 2;
constexpr size_t WS_ACT = WS_R;
constexpr size_t WS_U = WS_R;
constexpr size_t WS_QB = WS_U + (size_t)MTOK * 1792 * 2;
constexpr size_t WS_KB = WS_QB + (size_t)MTOK * 512 * 2;
constexpr size_t WS_VT = WS_KB + (size_t)MTOK * 128 * 2;
constexpr size_t WS_Z1 = WS_VT + (size_t)MTOK * 128 * 2;
constexpr size_t WS_HV = WS_R + (size_t)MTOK * 2816 * 2;
constexpr size_t WS_X1 = WS_HV + (size_t)MTOK * 256 * 2;
constexpr size_t WS_X2 = WS_X1 + (size_t)MTOK * 256 * 2;
constexpr size_t WS_FILT = WS_X2 + (size_t)MTOK * 256 * 2;
constexpr size_t SZ_FILT_S = (size_t)2 * 256 * 8192 * 2, SZ_FILT_P = (size_t)2 * 256 * 512 * 2, SZ_FILT_L = SZ_FILT_S + SZ_FILT_P;
constexpr size_t WS_FSC = WS_FILT + 2 * SZ_FILT_L;
constexpr size_t WS_H2 = WS_FSC + (size_t)2 * 2 * 2 * 256 * 4;
constexpr size_t WS_KC = WS_H2 + (size_t)2 * 4352 * 64 * 4;
constexpr size_t WS_VCT = WS_KC + (size_t)2 * 4 * 256 * 128 * 2;
constexpr size_t WS_END = WS_VCT + (size_t)2 * 4 * 256 * 128 * 2;
constexpr size_t WS_BAR = WS_END;
constexpr size_t WS_END2 = WS_BAR + (size_t)XCD_BAR_WORDS * 4;
static_assert(WS_Z1 + (size_t)MTOK * 256 * 2 <= WS_HV, "alias region overflow");

constexpr size_t OUT_K = (size_t)MTOK * 1024, OUT_V = OUT_K + (size_t)16 * 2 * 256 * 128;

struct Params { const float* in[30]; float* out; unsigned char* ws; int ph_lo, ph_hi; };

__device__ __forceinline__ int otid() { int t = threadIdx.x; asm volatile("" : "+v"(t)); return t; }
__device__ __forceinline__ float bf2f(bf16_t b) { return __uint_as_float(((unsigned)b) << 16); }
__device__ __forceinline__ float bflo(unsigned w) { return __uint_as_float(w << 16); }
__device__ __forceinline__ float bfhi(unsigned w) { return __uint_as_float(w & 0xffff0000u); }
__device__ __forceinline__ unsigned pk(float lo, float hi) { return pg8::cvt_pk_bf16(lo, hi); }
__device__ __forceinline__ bf16_t f2bf(float f) { return (bf16_t)(pk(f, 0.f) & 0xffffu); }
__device__ __forceinline__ void unpack8(const u32x4 w, float* x) { x[0] = bflo(w.x); x[1] = bfhi(w.x); x[2] = bflo(w.y); x[3] = bfhi(w.y); x[4] = bflo(w.z); x[5] = bfhi(w.z); x[6] = bflo(w.w); x[7] = bfhi(w.w); }
__device__ __forceinline__ u32x4 pack8(const float* x) { u32x4 w; w.x = pk(x[0], x[1]); w.y = pk(x[2], x[3]); w.z = pk(x[4], x[5]); w.w = pk(x[6], x[7]); return w; }

__device__ void mod_item(const Params& p, LAS unsigned char* lds, int it) {
    const int tid = otid(), l = it / 72, nt = it % 72;
    LAS float* sc = (LAS float*)lds;
    LAS float* red = (LAS float*)(lds + 20480);
    for (int i = tid; i < 5 * 1024; i += NTHR) { const int ci = i >> 10, k = i & 1023; const float v = ci == 0 ? p.in[5][k] : p.in[4][(ci - 1) * 1024 + k]; sc[i] = v / (1.f + expf(-v)); }
    __syncthreads();
    const int cq = tid & 31, kg = tid >> 5;
    const float* W = p.in[6] + (size_t)l * 1024 * 9216 + nt * 128 + cq * 4;
    f32x4 acc[5];
#pragma unroll
    for (int ci = 0; ci < 5; ++ci) acc[ci] = (f32x4){0.f, 0.f, 0.f, 0.f};
#pragma unroll 4
    for (int kk = 0; kk < 64; ++kk) { const int k = kg * 64 + kk; const f32x4 w = *(const f32x4*)(W + (size_t)k * 9216);
#pragma unroll
        for (int ci = 0; ci < 5; ++ci) acc[ci] += sc[ci * 1024 + k] * w; }
#pragma unroll
    for (int ci = 0; ci < 5; ++ci)
#pragma unroll
        for (int j = 0; j < 4; ++j) red[(kg * 5 + ci) * 128 + cq * 4 + j] = acc[ci][j];
    __syncthreads();
    float* mod = (float*)(p.ws + WS_MOD);
    for (int i = tid; i < 640; i += NTHR) { const int ci = i >> 7, n = i & 127; float s = 0.f;
#pragma unroll
        for (int g = 0; g < 16; ++g) s += red[(g * 5 + ci) * 128 + n];
        mod[(size_t)(l * 5 + ci) * 9216 + nt * 128 + n] = s + p.in[7][l * 9216 + nt * 128 + n]; }
    __syncthreads();
}

__device__ void h2_item(const Params& p, int idx) {
    const int tid = otid(), lane = tid & 63, wave = tid >> 6;
    const int rowid = idx * 8 + wave, l = rowid / 4352, rr = rowid % 4352, Lsel = rr < 256 ? 0 : 1, t = Lsel ? rr - 256 : rr, L = Lsel ? 4096 : 256;
    float zv = 0.f;
    { const float tl = (float)t / (float)(L - 1); const float w = 6.283185307179586f * (float)t / (float)L;
      if (lane == 0) zv = tl;
      else if (lane <= 16) { const float f = 1e-4f + (float)(lane - 1) * ((15.f - 1e-4f) / 15.f); zv = cosf(f * w); }
      else if (lane <= 32) { const float f = 1e-4f + (float)(lane - 17) * ((15.f - 1e-4f) / 15.f); zv = -sinf(f * w); } }
    const float* w1 = p.in[21] + l * 33 * 64; const float* w2 = p.in[23] + l * 4096; const float* fr = p.in[27] + l * 128;
    float a = 0.f;
    for (int e = 0; e < 33; ++e) a += __shfl(zv, e) * w1[e * 64 + lane];
    a = sinf(fr[lane] * (a + p.in[22][l * 64 + lane]));
    float b = 0.f;
    for (int i = 0; i < 64; ++i) b += __shfl(a, i) * w2[i * 64 + lane];
    b = sinf(fr[64 + lane] * (b + p.in[24][l * 64 + lane]));
    ((float*)(p.ws + WS_H2))[((size_t)l * 4352 + rr) * 64 + lane] = b;
}

__device__ void cache_item(const Params& p, int idx) {
    const int tid = otid();
    const bool isv = idx >= 64; const int base = (idx & 63) * 4096;
    bf16_t* dst = (bf16_t*)(p.ws + (isv ? WS_VCT : WS_KC)); const float* src = p.in[isv ? 3 : 2];
#pragma unroll
    for (int i = 0; i < 8; ++i) { const int o = base + i * 512 + tid; int l, b, s, e;
        if (!isv) { e = o & 127; s = (o >> 7) & 255; b = (o >> 15) & 3; l = o >> 17; }
        else { s = o & 255; e = (o >> 8) & 127; b = (o >> 15) & 3; l = o >> 17; }
        dst[o] = f2bf(src[((size_t)(b * 2 + l) * 256 + s) * 128 + e]); }
}

__device__ void transpose_item(const Params& p, LAS unsigned char* lds, int idx) {
    const int tid = otid();
    const int l = idx / 4928, rem = idx % 4928; const float* src; bf16_t* dst; int K, N, kt, nt, mode = 0;
    if (rem < 4224) { const int f = rem / 2112, r2 = rem % 2112, kind = r2 / 704, t = r2 % 704, lf = l * 2 + f;
        if (kind < 2) { src = p.in[9 + kind] + (size_t)lf * 1024 * 2816; K = 1024; N = 2816; kt = t / 44; nt = t % 44; dst = (bf16_t*)(p.ws + WS_WGU + lf * SZ_WGU); mode = 1 + kind; }
        else { src = p.in[11] + (size_t)lf * 2816 * 1024; K = 2816; N = 1024; kt = t / 16; nt = t % 16; dst = (bf16_t*)(p.ws + WS_WD + lf * SZ_WD); } }
    else if (rem < 4672) { const int t = rem - 4224; src = p.in[12] + (size_t)l * 1024 * 1792; K = 1024; N = 1792; kt = t / 28; nt = t % 28; dst = (bf16_t*)(p.ws + WS_WIN + l * SZ_WIN); }
    else { const int t = rem - 4672; src = p.in[13] + (size_t)l * 1024 * 1024; K = 1024; N = 1024; kt = t / 16; nt = t % 16; dst = (bf16_t*)(p.ws + WS_WOUT + l * SZ_WOUT); }
    LAS float* T = (LAS float*)lds;
#pragma unroll
    for (int i = 0; i < 2; ++i) { const int e = tid + i * 512, kr = e >> 4, c4 = e & 15; const f32x4 v = *(const f32x4*)(src + (size_t)(kt * 64 + kr) * N + nt * 64 + c4 * 4);
#pragma unroll
        for (int j = 0; j < 4; ++j) T[kr * 65 + c4 * 4 + j] = v[j]; }
    __syncthreads();
    { const int n = tid >> 3, kc = tid & 7, ng = nt * 64 + n; const int drow = mode == 0 ? ng : ((ng >> 4) * 32 + (mode == 2 ? 16 : 0) + (ng & 15));
      float x[8];
#pragma unroll
      for (int j = 0; j < 8; ++j) x[j] = T[(kc * 8 + j) * 65 + n];
      *(u32x4*)(dst + (size_t)drow * K + kt * 64 + kc * 8) = pack8(x); }
    __syncthreads();
}

__device__ void ph_prep(const Params& p, LAS unsigned char* lds) {
    constexpr int N_MOD = 144, N_H2 = 1088, N_CACHE = 128, N_TR = 9856;
    for (int it = blockIdx.x; it < N_MOD + N_H2 + N_CACHE + N_TR; it += gridDim.x) {
        if (it < N_MOD) mod_item(p, lds, it);
        else if (it < N_MOD + N_H2) h2_item(p, it - N_MOD);
        else if (it < N_MOD + N_H2 + N_CACHE) cache_item(p, it - N_MOD - N_H2);
        else transpose_item(p, lds, it - N_MOD - N_H2 - N_CACHE);
    }
}

__device__ __forceinline__ bf16_t* filt_ptr(const Params& p, int l, int Lsel) { return (bf16_t*)(p.ws + WS_FILT + l * SZ_FILT_L + (Lsel ? 0 : SZ_FILT_S)); }

__device__ void filter_item(const Params& p, LAS unsigned char* lds, int fidx) {
    const int tid = otid(), lane = tid & 63, wave = tid >> 6;
    const int Lsel = fidx < 256 ? 1 : 0, f2 = fidx & 255, l = f2 >> 7, o = (f2 >> 6) & 1, cg4 = f2 & 63, L = Lsel ? 4096 : 256;
    LAS float* w3s = (LAS float*)lds;
    LAS float* red = (LAS float*)(lds + 2048);
    { const int ii = tid >> 3, q = tid & 7; w3s[tid] = p.in[25][(size_t)l * 64 * 1024 + ii * 1024 + (q >> 2) * 512 + o * 256 + cg4 * 4 + (q & 3)]; }
    __syncthreads();
    float b3v[8], del[4], asum[4];
#pragma unroll
    for (int q = 0; q < 8; ++q) b3v[q] = p.in[26][l * 1024 + (q >> 2) * 512 + o * 256 + cg4 * 4 + (q & 3)];
#pragma unroll
    for (int cc = 0; cc < 4; ++cc) { del[cc] = fabsf(p.in[28][l * 512 + o * 256 + cg4 * 4 + cc]); asum[cc] = 0.f; }
    const float* H = (const float*)(p.ws + WS_H2) + ((size_t)l * 4352 + (Lsel ? 256 : 0)) * 64;
    bf16_t* Gb = filt_ptr(p, l, Lsel) + (size_t)(o * 256 + cg4 * 4) * (2 * L);
#pragma unroll 1
    for (int t = tid; t < L; t += NTHR) {
        const float* hp = H + (size_t)t * 64;
        f32x4 a0 = (f32x4){0.f, 0.f, 0.f, 0.f}, a1 = a0;
        f32x4 cur = *(const f32x4*)hp;
#pragma unroll 1
        for (int i = 0; i < 16; ++i) {
            const f32x4 nxt = *(const f32x4*)(hp + ((i + 1) & 15) * 4);
            const LAS float* wp = w3s + i * 32;
#pragma unroll
            for (int j = 0; j < 4; ++j) { const f32x4 wa = *(const LAS f32x4*)(wp + j * 8), wb = *(const LAS f32x4*)(wp + j * 8 + 4); a0 += cur[j] * wa; a1 += cur[j] * wb; }
            cur = nxt;
        }
        const float tl = (float)t / (float)(L - 1);
#pragma unroll
        for (int cc = 0; cc < 4; ++cc) { const float dec = expf(-tl * del[cc]) + 0.05f; const float kf = (a0[cc] + b3v[cc]) * dec, kb = (a1[cc] + b3v[4 + cc]) * dec;
            Gb[(size_t)cc * 2 * L + (L - t)] = f2bf(kf); asum[cc] += fabsf(kf);
            if (t >= 1) { Gb[(size_t)cc * 2 * L + L + t] = f2bf(kb); asum[cc] += fabsf(kb); } }
    }
    if (tid < 4) Gb[(size_t)tid * 2 * L] = 0;
#pragma unroll
    for (int cc = 0; cc < 4; ++cc) { float v = asum[cc];
#pragma unroll
        for (int off = 32; off >= 1; off >>= 1) v += __shfl_xor(v, off);
        if (lane == 0) red[wave * 4 + cc] = v; }
    __syncthreads();
    if (tid < 4) { float s = 0.f;
#pragma unroll
        for (int w = 0; w < 8; ++w) s += red[w * 4 + tid];
        ((float*)(p.ws + WS_FSC))[((l * 2 + Lsel) * 2 + o) * 256 + cg4 * 4 + tid] = 1.0f / (s + 1e-6f); }
    __syncthreads();
}

__device__ void ph_norm(const Params& p, int l, int ni, const float* xp, const float* xs) {
    const int tid = otid(), lane = tid & 63, wave = tid >> 6;
    const float* nw = p.in[8] + (l * 3 + ni) * 1024; const float* mod = (const float*)(p.ws + WS_MOD) + (size_t)l * 5 * 9216;
    bf16_t* ab = (bf16_t*)(p.ws + WS_ABUF);
    for (int row = blockIdx.x * 8 + wave; row < MTOK; row += gridDim.x * 8) {
        const float* src = row < MPR ? xp + (size_t)row * 1024 : xs + (size_t)(row - MPR) * 1024; const int ci = row < MPR ? 0 : 1 + ((row - MPR) >> 12);
        f32x4 v[4]; float ss = 0.f;
#pragma unroll
        for (int i = 0; i < 4; ++i) { v[i] = *(const f32x4*)(src + i * 256 + lane * 4); ss += v[i][0] * v[i][0] + v[i][1] * v[i][1] + v[i][2] * v[i][2] + v[i][3] * v[i][3]; }
#pragma unroll
        for (int off = 32; off >= 1; off >>= 1) ss += __shfl_xor(ss, off);
        const float rstd = rsqrtf(ss * (1.0f / 1024.0f) + 1e-6f);
        const float* msh = mod + (size_t)ci * 9216 + (3 * ni) * 1024; const float* msc = msh + 1024;
#pragma unroll
        for (int i = 0; i < 4; ++i) { const int col = i * 256 + lane * 4; const f32x4 g = *(const f32x4*)(nw + col), sc = *(const f32x4*)(msc + col), sh = *(const f32x4*)(msh + col);
            const f32x4 y = v[i] * rstd * g * (1.0f + sc) + sh; u32x2 w; w.x = pk(y[0], y[1]); w.y = pk(y[2], y[3]);
            *(u32x2*)(ab + (size_t)row * 1024 + col) = w; }
    }
}

struct EpiSwiglu {
    static constexpr bool PERM = false, AFTER_DRAIN = false;
    bf16_t* act;
    __device__ __forceinline__ void operator()(const f32x4 (&acc)[2][2][4][2], const pg8::Unit& u, int wr, int wc, int fr, int fq) const {
        const int row0 = u.pm * 256 + wr * 64 + fr, col0 = u.pn * 128 + wc * 16 + 4 * fq;
#pragma unroll
        for (int ai = 0; ai < 2; ++ai)
#pragma unroll
            for (int m = 0; m < 4; ++m) { bf16_t* rowp = act + (size_t)(row0 + ai * 128 + m * 16) * 2816 + col0;
#pragma unroll
                for (int bj = 0; bj < 2; ++bj) { const f32x4 g = acc[ai][bj][m][0], uu = acc[ai][bj][m][1]; float o[4];
#pragma unroll
                    for (int j = 0; j < 4; ++j) o[j] = g[j] / (1.0f + __expf(-g[j])) * uu[j];
                    u32x2 w; w.x = pk(o[0], o[1]); w.y = pk(o[2], o[3]); *(u32x2*)(rowp + bj * 64) = w; } }
    }
};
struct EpiResid {
    static constexpr bool PERM = false, AFTER_DRAIN = false;
    const float* xp; const float* xs; float* out; const float* gate; float coef;
    __device__ __forceinline__ void operator()(const f32x4 (&acc)[2][2][4][2], const pg8::Unit& u, int wr, int wc, int fr, int fq) const {
        const int row0 = u.pm * 256 + wr * 64 + fr, col0 = u.pn * 256 + wc * 32 + 4 * fq; const int ci = u.pm < 16 ? 0 : 1 + ((u.pm - 16) >> 4);
        const float* gp = gate + (size_t)ci * 9216 + col0; f32x4 gv[2][2];
#pragma unroll
        for (int bj = 0; bj < 2; ++bj)
#pragma unroll
            for (int n = 0; n < 2; ++n) gv[bj][n] = *(const f32x4*)(gp + bj * 128 + n * 16) * coef;
#pragma unroll
        for (int ai = 0; ai < 2; ++ai)
#pragma unroll
            for (int m = 0; m < 4; ++m) { const int r = row0 + ai * 128 + m * 16; const float* src = (r < MPR ? xp + (size_t)r * 1024 : xs + (size_t)(r - MPR) * 1024) + col0; float* dst = out + (size_t)r * 1024 + col0;
#pragma unroll
                for (int bj = 0; bj < 2; ++bj)
#pragma unroll
                    for (int n = 0; n < 2; ++n) { const f32x4 x = *(const f32x4*)(src + bj * 128 + n * 16); *(f32x4*)(dst + bj * 128 + n * 16) = x + gv[bj][n] * acc[ai][bj][m][n]; }
                asm volatile("" ::: "memory"); }
    }
};
struct EpiStore {
    static constexpr bool PERM = false, AFTER_DRAIN = false;
    bf16_t* O; int ldc;
    __device__ __forceinline__ void operator()(const f32x4 (&acc)[2][2][4][2], const pg8::Unit& u, int wr, int wc, int fr, int fq) const {
        const int row0 = u.pm * 256 + wr * 64 + fr, col0 = u.pn * 256 + wc * 32 + 4 * fq;
#pragma unroll
        for (int ai = 0; ai < 2; ++ai)
#pragma unroll
            for (int m = 0; m < 4; ++m) { bf16_t* rowp = O + (size_t)(row0 + ai * 128 + m * 16) * ldc + col0;
#pragma unroll
                for (int bj = 0; bj < 2; ++bj)
#pragma unroll
                    for (int n = 0; n < 2; ++n) { const f32x4 v = acc[ai][bj][m][n]; u32x2 w; w.x = pk(v[0], v[1]); w.y = pk(v[2], v[3]); *(u32x2*)(rowp + bj * 128 + n * 16) = w; } }
    }
};

__device__ __forceinline__ void tile_info(int row0, int& rowbase, int& L, int& s0) {
    if (row0 < MPR) { rowbase = row0 & ~255; L = 256; s0 = row0 & 255; } else { const int r = row0 - MPR; rowbase = MPR + (r & ~4095); L = 4096; s0 = r & 4095; }
}

__device__ void pool_item(const Params& p, LAS unsigned char* lds, int l, int tile, int g) {
    const int tid = otid(); int rowbase, L, s0; tile_info(tile * 64, rowbase, L, s0);
    const bf16_t* U = (const bf16_t*)(p.ws + WS_U);
    LAS float* dl = (LAS float*)lds;
    LAS float* wl = (LAS float*)(lds + 64 * 65 * 4);
    { const float* W = p.in[14] + (size_t)(l * 4 + g) * 4096;
#pragma unroll
      for (int i = 0; i < 2; ++i) { const int e = tid + i * 512; *(LAS f32x4*)(wl + e * 4) = *(const f32x4*)(W + e * 4); } }
    { const int t = tid >> 3, cs = tid & 7, s = s0 + t, half = 1 << g;
      const int lo = max(s - half, 0), hi = min(s + half, L);
      float sum[8], x[8];
#pragma unroll
      for (int j = 0; j < 8; ++j) sum[j] = 0.f;
      for (int sp = lo; sp < hi; ++sp) { const u32x4 w = *(const u32x4*)(U + (size_t)(rowbase + sp) * 1792 + g * 64 + cs * 8); unpack8(w, x);
#pragma unroll
          for (int j = 0; j < 8; ++j) sum[j] += x[j]; }
      const u32x4 w = *(const u32x4*)(U + (size_t)(rowbase + s) * 1792 + g * 64 + cs * 8); unpack8(w, x);
      const float inv = 1.0f / (float)(hi - lo);
#pragma unroll
      for (int j = 0; j < 8; ++j) dl[t * 65 + cs * 8 + j] = sum[j] * inv - x[j]; }
    __syncthreads();
    { const int t = tid >> 3, dq = tid & 7; float o[8];
#pragma unroll
      for (int j = 0; j < 8; ++j) o[j] = 0.f;
#pragma unroll 8
      for (int c = 0; c < 64; ++c) { const float d = dl[t * 65 + c]; const f32x4 wa = *(const LAS f32x4*)(wl + c * 64 + dq * 8), wb = *(const LAS f32x4*)(wl + c * 64 + dq * 8 + 4);
#pragma unroll
          for (int j = 0; j < 4; ++j) { o[j] += d * wa[j]; o[4 + j] += d * wb[j]; } }
      const float* scl = p.in[15] + l * 256 + g * 64 + dq * 8;
#pragma unroll
      for (int j = 0; j < 8; ++j) o[j] *= scl[j];
      *(u32x4*)((bf16_t*)(p.ws + WS_ABUF) + (size_t)(tile * 64 + t) * 1024 + g * 64 + dq * 8) = pack8(o); }
    __syncthreads();
}

__device__ void qk_item(const Params& p, int l, int tile) {
    const int tid = otid(); int rowbase, L, s0; tile_info(tile * 64, rowbase, L, s0);
    const bf16_t* U = (const bf16_t*)(p.ws + WS_U); const bool lat = L == 4096;
    bf16_t* QB = (bf16_t*)(p.ws + WS_QB); bf16_t* KB = (bf16_t*)(p.ws + WS_KB);
    for (int pass = 0; pass < 10; ++pass) {
        const int idx = pass * 512 + tid, e = idx & 7, hh = (idx % 80) >> 3, t = idx / 80, row = tile * 64 + t, s = s0 + t;
        const bool isq = hh < 8; const int colbase = isq ? 256 + hh * 64 : 768 + (hh - 8) * 64;
        float x[8]; unpack8(*(const u32x4*)(U + (size_t)row * 1792 + colbase + e * 8), x);
        float ss = 0.f;
#pragma unroll
        for (int j = 0; j < 8; ++j) ss += x[j] * x[j];
        ss += __shfl_xor(ss, 1); ss += __shfl_xor(ss, 2); ss += __shfl_xor(ss, 4);
        const float rstd = rsqrtf(ss * (1.0f / 64.0f) + 1e-6f);
        const float* nw = p.in[isq ? 16 : 17] + l * 64 + e * 8;
#pragma unroll
        for (int j = 0; j < 8; ++j) x[j] = x[j] * rstd * nw[j];
        if (lat) {
            const float pos = (float)((e < 4) ? (s >> 6) : (s & 63));
#pragma unroll
            for (int j = 0; j < 8; ++j) { const float xp = __shfl_xor(x[j], 2); const int fi = (e & 1) * 8 + j;
                const float ang = pos * expf(-(float)fi * (9.210340371976184f / 16.0f)); const float cs = cosf(ang), sn = sinf(ang);
                x[j] = (e & 2) ? (x[j] * cs + xp * sn) : (x[j] * cs - xp * sn); }
        }
        const u32x4 w = pack8(x);
        if (isq) *(u32x4*)(QB + (size_t)row * 512 + hh * 64 + e * 8) = w;
        else { *(u32x4*)(KB + (size_t)row * 128 + (hh - 8) * 64 + e * 8) = w;
            if (!lat) { const int b = row >> 8, sq = row & 255; float* o = p.out + OUT_K + ((size_t)(b * 2 + l) * 256 + sq) * 128 + (hh - 8) * 64 + e * 8;
                *(f32x4*)o = (f32x4){x[0], x[1], x[2], x[3]}; *(f32x4*)(o + 4) = (f32x4){x[4], x[5], x[6], x[7]}; } }
    }
}

__device__ void chunk_item(const Params& p, LAS unsigned char* lds, int l, int tile, int ch) {
    const int tid = otid(); int rowbase, L, s0; tile_info(tile * 64, rowbase, L, s0);
    const bf16_t* U = (const bf16_t*)(p.ws + WS_U);
    LAS bf16_t* T = (LAS bf16_t*)lds;
    { const int t = tid >> 3, cs = tid & 7, s = s0 + t, row = tile * 64 + t; float v[16];
      if (ch == 0) { const int col0 = 896 + cs * 16;
          unpack8(*(const u32x4*)(U + (size_t)row * 1792 + col0), v); unpack8(*(const u32x4*)(U + (size_t)row * 1792 + col0 + 8), v + 8);
          if (L == 256) { const int b = row >> 8, sq = row & 255; float* o = p.out + OUT_V + ((size_t)(b * 2 + l) * 256 + sq) * 128 + cs * 16;
#pragma unroll
              for (int q = 0; q < 4; ++q) *(f32x4*)(o + q * 4) = (f32x4){v[q * 4], v[q * 4 + 1], v[q * 4 + 2], v[q * 4 + 3]}; } }
      else { const int cc0 = (ch - 1) * 128 + cs * 16, col0 = 1024 + cc0; float a[16], b[16], c[16];
          unpack8(*(const u32x4*)(U + (size_t)row * 1792 + col0), b); unpack8(*(const u32x4*)(U + (size_t)row * 1792 + col0 + 8), b + 8);
          if (s > 0) { unpack8(*(const u32x4*)(U + (size_t)(row - 1) * 1792 + col0), a); unpack8(*(const u32x4*)(U + (size_t)(row - 1) * 1792 + col0 + 8), a + 8); }
          else {
#pragma unroll
              for (int j = 0; j < 16; ++j) a[j] = 0.f; }
          if (s < L - 1) { unpack8(*(const u32x4*)(U + (size_t)(row + 1) * 1792 + col0), c); unpack8(*(const u32x4*)(U + (size_t)(row + 1) * 1792 + col0 + 8), c + 8); }
          else {
#pragma unroll
              for (int j = 0; j < 16; ++j) c[j] = 0.f; }
          const float* sw = p.in[19] + (size_t)l * 3 * 768 + cc0; const float* sb = p.in[20] + l * 768 + cc0;
#pragma unroll
          for (int j = 0; j < 16; ++j) v[j] = a[j] * sw[j] + b[j] * sw[768 + j] + c[j] * sw[1536 + j] + sb[j]; }
      *(LAS u32x4*)(T + t * 136 + cs * 16) = pack8(v); *(LAS u32x4*)(T + t * 136 + cs * 16 + 8) = pack8(v + 8); }
    __syncthreads();
    { const int col = tid >> 2, qd = tid & 3; bf16_t* dst;
      if (ch == 0) dst = (bf16_t*)(p.ws + WS_VT) + (size_t)rowbase * 128 + (size_t)col * L;
      else { const int cc = (ch - 1) * 128 + col, which = cc >> 8, c = cc & 255; dst = (bf16_t*)(p.ws + (which == 0 ? WS_HV : (which == 1 ? WS_X1 : WS_X2))) + (size_t)rowbase * 256 + (size_t)c * L; }
      unsigned w[8];
#pragma unroll
      for (int i = 0; i < 8; ++i) { const unsigned lo = T[(qd * 16 + 2 * i) * 136 + col], hi = T[(qd * 16 + 2 * i + 1) * 136 + col]; w[i] = lo | (hi << 16); }
      *(u32x4*)(dst + s0 + qd * 16) = (u32x4){w[0], w[1], w[2], w[3]}; *(u32x4*)(dst + s0 + qd * 16 + 8) = (u32x4){w[4], w[5], w[6], w[7]}; }
    __syncthreads();
}

__device__ void ph_mixprep(const Params& p, LAS unsigned char* lds, int l) {
    for (int it = blockIdx.x; it < 320 * 12; it += gridDim.x) { const int tile = it / 12, sub = it % 12;
        if (sub < 4) pool_item(p, lds, l, tile, sub);
        else if (sub == 4) qk_item(p, l, tile);
        else chunk_item(p, lds, l, tile, sub - 5); }
}

__device__ void attn_item(const Params& p, LAS unsigned char* lds, int l, bool lat, int b, int nb, int half, int kvh) {
    const int tid = otid(), lane = tid & 63, wave = tid >> 6, r = lane & 31, h = lane >> 5;
    const int gq = wave >> 1, hq = kvh * 4 + gq;
    const int L = lat ? 4096 : 256, rowbase = lat ? MPR + b * 4096 : b * 256;
    const bf16_t* QB = (const bf16_t*)(p.ws + WS_QB); const bf16_t* KB = (const bf16_t*)(p.ws + WS_KB); const bf16_t* VT = (const bf16_t*)(p.ws + WS_VT);
    int klo = 0, nt1 = 0; const bf16_t *K1 = KB, *V1 = VT, *K2, *V2;
    if (lat) { klo = max(0, (nb - 1) * 128); const int khi = min(L, (nb + 2) * 128); nt1 = (khi - klo) >> 6;
        K1 = KB + (size_t)(rowbase + klo) * 128 + kvh * 64; V1 = VT + (size_t)rowbase * 128 + (size_t)(kvh * 64) * L + klo;
        K2 = (const bf16_t*)(p.ws + WS_KC) + (size_t)((l * 4 + b) * 256) * 128 + kvh * 64; V2 = (const bf16_t*)(p.ws + WS_VCT) + (size_t)((l * 4 + b) * 128 + kvh * 64) * 256; }
    else { K2 = KB + (size_t)rowbase * 128 + kvh * 64; V2 = VT + (size_t)rowbase * 128 + (size_t)(kvh * 64) * 256; }
    LAS bf16_t* Ks = (LAS bf16_t*)lds;
    LAS bf16_t* Vs = (LAS bf16_t*)(lds + 64 * 72 * 2);
    const int qoff = nb * 128 + half * 64 + (wave & 1) * 32; const int qrow0 = rowbase + qoff;
    bf16x8 Q[4];
#pragma unroll
    for (int ks = 0; ks < 4; ++ks) Q[ks] = *(const bf16x8*)(QB + (size_t)(qrow0 + r) * 512 + hq * 64 + 16 * ks + 8 * h);
    f32x16 O[2];
#pragma unroll
    for (int a = 0; a < 2; ++a)
#pragma unroll
        for (int q = 0; q < 16; ++q) O[a][q] = 0.f;
    const float sinkv = p.in[18][l * 8 + hq];
    float mrun = sinkv, lsum = h == 0 ? 1.f : 0.f;
    const int ldrow = tid >> 3, ldseg = tid & 7;
    for (int ti = 0; ti < nt1 + 4; ++ti) {
        const bool masked = ti < nt1; const bf16_t *Kp, *Vp; int vs, kpos0 = 0;
        if (masked) { Kp = K1 + (size_t)ti * 64 * 128; Vp = V1 + ti * 64; vs = L; kpos0 = klo + ti * 64; } else { const int j = ti - nt1; Kp = K2 + (size_t)j * 64 * 128; Vp = V2 + j * 64; vs = 256; }
        const u32x4 kreg = *(const u32x4*)(Kp + (size_t)ldrow * 128 + ldseg * 8), vreg = *(const u32x4*)(Vp + (size_t)ldrow * vs + ldseg * 8);
        __syncthreads();
        *(LAS u32x4*)(Ks + ldrow * 72 + ldseg * 8) = kreg; *(LAS u32x4*)(Vs + ldrow * 72 + ldseg * 8) = vreg;
        __syncthreads();
        {
            f32x16 S[2];
#pragma unroll
            for (int kb2 = 0; kb2 < 2; ++kb2) {
#pragma unroll
                for (int q = 0; q < 16; ++q) S[kb2][q] = 0.f;
#pragma unroll
                for (int ks = 0; ks < 4; ++ks) { const bf16x8 kf = *(const LAS bf16x8*)(Ks + (32 * kb2 + r) * 72 + 16 * ks + 8 * h);
                    S[kb2] = __builtin_amdgcn_mfma_f32_32x32x16_bf16(kf, Q[ks], S[kb2], 0, 0, 0); } }
            const int qpos = qoff + r;
            float mx = -3.0e38f;
#pragma unroll
            for (int kb2 = 0; kb2 < 2; ++kb2)
#pragma unroll
                for (int q = 0; q < 16; ++q) { float sv = S[kb2][q] * 0.125f;
                    if (masked) { const int kpos = kpos0 + 32 * kb2 + (q & 3) + 8 * (q >> 2) + 4 * h; const int df = kpos - qpos; if (df > 128 || df < -128) sv = -1.0e30f; }
                    S[kb2][q] = sv; mx = fmaxf(mx, sv); }
            mx = fmaxf(mx, __shfl_xor(mx, 32));
            const float mnew = fmaxf(mrun, mx), alpha = __expf(mrun - mnew); mrun = mnew;
            float psum = 0.f;
#pragma unroll
            for (int kb2 = 0; kb2 < 2; ++kb2)
#pragma unroll
                for (int q = 0; q < 16; ++q) { const float pv = __expf(S[kb2][q] - mnew); S[kb2][q] = pv; psum += pv; }
            lsum = lsum * alpha + psum;
#pragma unroll
            for (int db = 0; db < 2; ++db)
#pragma unroll
                for (int q = 0; q < 16; ++q) O[db][q] *= alpha;
#pragma unroll
            for (int kb2 = 0; kb2 < 2; ++kb2)
#pragma unroll
                for (int s = 0; s < 2; ++s) { u32x4 pw; pw.x = pk(S[kb2][8 * s], S[kb2][8 * s + 1]); pw.y = pk(S[kb2][8 * s + 2], S[kb2][8 * s + 3]); pw.z = pk(S[kb2][8 * s + 4], S[kb2][8 * s + 5]); pw.w = pk(S[kb2][8 * s + 6], S[kb2][8 * s + 7]);
                    const bf16x8 pf = __builtin_bit_cast(bf16x8, pw);
#pragma unroll
                    for (int db = 0; db < 2; ++db) { const LAS bf16_t* vp = Vs + (32 * db + r) * 72 + 32 * kb2 + 16 * s + 4 * h;
                        const u32x2 v0 = *(const LAS u32x2*)vp, v1 = *(const LAS u32x2*)(vp + 8); const u32x4 vw = (u32x4){v0.x, v0.y, v1.x, v1.y};
                        O[db] = __builtin_amdgcn_mfma_f32_32x32x16_bf16(__builtin_bit_cast(bf16x8, vw), pf, O[db], 0, 0, 0); } }
        }
    }
    bf16_t* MX = (bf16_t*)(p.ws + WS_ABUF);
    { const float lt = lsum + __shfl_xor(lsum, 32); const float inv = 1.0f / lt;
        bf16_t* orow = MX + (size_t)(qrow0 + r) * 1024 + 256 + hq * 64;
#pragma unroll
        for (int db = 0; db < 2; ++db)
#pragma unroll
            for (int g4 = 0; g4 < 4; ++g4) { u32x2 w; w.x = pk(O[db][4 * g4] * inv, O[db][4 * g4 + 1] * inv); w.y = pk(O[db][4 * g4 + 2] * inv, O[db][4 * g4 + 3] * inv);
                *(u32x2*)(orow + 32 * db + 8 * g4 + 4 * h) = w; } }
    __syncthreads();
}

__device__ void conv_item(const Params& p, LAS unsigned char* lds, int l, bool smp, int c, int order) {
    const int tid = otid(), lane = tid & 63, wave = tid >> 6, r = lane & 31, h = lane >> 5;
    const int L = smp ? 4096 : 256, NB = smp ? 4 : 16, rowbase0 = smp ? MPR : 0, Lsel = smp ? 1 : 0;
    const int nblk = L >> 5, Iper = 32 / NB, npairs = nblk / (2 * Iper);
    constexpr int PADE = 480;
    const int zstride = L + 2 * PADE;
    LAS bf16_t* zs = (LAS bf16_t*)lds;
    LAS bf16_t* fl = (LAS bf16_t*)(lds + (size_t)NB * zstride * 2);
    const bf16_t* zin = (const bf16_t*)(p.ws + (order == 0 ? WS_HV : WS_Z1));
    const bf16_t* gate = (const bf16_t*)(p.ws + (order == 0 ? WS_X1 : WS_X2));
    const bf16_t* filt = filt_ptr(p, l, Lsel) + (size_t)(order * 256 + c) * (2 * L);
    const float fs = ((const float*)(p.ws + WS_FSC))[((l * 2 + Lsel) * 2 + order) * 256 + c];
    const float bd = p.in[29][l * 512 + order * 256 + c];
    const int nch = L >> 3;
    for (int i = tid; i < NB * nch; i += NTHR) { const int b = i / nch, ch = i % nch;
        *(LAS u32x4*)(zs + b * zstride + PADE + ch * 8) = *(const u32x4*)(zin + (size_t)(rowbase0 + b * L) * 256 + (size_t)c * L + ch * 8); }
    for (int i = tid; i < NB * 120; i += NTHR) { const int b = i / 120, q = i % 120; const int off = q < 60 ? q * 8 : PADE + L + (q - 60) * 8;
        *(LAS u32x4*)(zs + b * zstride + off) = (u32x4){0u, 0u, 0u, 0u}; }
    for (int i = tid; i < (2 * L) / 8; i += NTHR) *(LAS u32x4*)(fl + i * 8) = *(const u32x4*)(filt + i * 8);
    __syncthreads();
    const int bcol = r % NB, Iloc = r / NB;
    for (int gp = wave; gp < npairs; gp += 8) {
        const int I0a = 2 * gp * Iper, I0b = I0a + Iper;
        f32x16 acc[2];
#pragma unroll
        for (int q = 0; q < 16; ++q) { acc[0][q] = 0.f; acc[1][q] = 0.f; }
        const int Dlo = I0a - (nblk - 1), Dhi = I0b + Iper - 1;
        const LAS bf16_t* zb = zs + bcol * zstride + PADE + 8 * h;
        for (int D = Dlo; D <= Dhi; ++D) {
            const int st = L - 32 * D - r + 8 * h;
            bf16x8 af[2];
#pragma unroll
            for (int ks = 0; ks < 2; ++ks)
#pragma unroll
                for (int j = 0; j < 8; ++j) af[ks][j] = (short)fl[st + 16 * ks + j];
#pragma unroll
            for (int x = 0; x < 2; ++x) { const int J = (x ? I0b : I0a) + Iloc - D;
#pragma unroll
                for (int ks = 0; ks < 2; ++ks) { const bf16x8 bfr = *(const LAS bf16x8*)(zb + 32 * J + 16 * ks);
                    acc[x] = __builtin_amdgcn_mfma_f32_32x32x16_bf16(af[ks], bfr, acc[x], 0, 0, 0); } }
        }
#pragma unroll
        for (int x = 0; x < 2; ++x) { const int I = (x ? I0b : I0a) + Iloc; const int rb = rowbase0 + bcol * L;
#pragma unroll
            for (int g4 = 0; g4 < 4; ++g4) { const int t0 = 32 * I + 8 * g4 + 4 * h;
                const u32x2 zc = *(const LAS u32x2*)(zs + bcol * zstride + PADE + t0);
                const size_t gi = (size_t)rb * 256 + (size_t)c * L + t0;
                const u32x2 gw = *(const u32x2*)(gate + gi);
                float o[4];
                o[0] = bflo(gw.x) * (acc[x][4 * g4] * fs + bd * bflo(zc.x)); o[1] = bfhi(gw.x) * (acc[x][4 * g4 + 1] * fs + bd * bfhi(zc.x));
                o[2] = bflo(gw.y) * (acc[x][4 * g4 + 2] * fs + bd * bflo(zc.y)); o[3] = bfhi(gw.y) * (acc[x][4 * g4 + 3] * fs + bd * bfhi(zc.y));
                if (order == 0) { u32x2 w; w.x = pk(o[0], o[1]); w.y = pk(o[2], o[3]); *(u32x2*)((bf16_t*)(p.ws + WS_Z1) + gi) = w; }
                else { bf16_t* mp = (bf16_t*)(p.ws + WS_ABUF) + (size_t)(rb + t0) * 1024 + 768 + c;
#pragma unroll
                    for (int j = 0; j < 4; ++j) mp[(size_t)j * 1024] = f2bf(o[j]); } } }
    }
    __syncthreads();
}

__device__ void ph_attn_conv1(const Params& p, LAS unsigned char* lds, int l) {
    for (int it = blockIdx.x; it < 1152; it += gridDim.x) {
        if (it < 256) conv_item(p, lds, l, true, it, 0);
        else if (it < 768) { const int a = it - 256; attn_item(p, lds, l, true, a >> 7, (a >> 2) & 31, (a >> 1) & 1, a & 1); }
        else if (it < 1024) conv_item(p, lds, l, false, it - 768, 0);
        else { const int a = it - 1024; attn_item(p, lds, l, false, a >> 3, (a >> 2) & 1, (a >> 1) & 1, a & 1); }
    }
}
__device__ void ph_conv2(const Params& p, LAS unsigned char* lds, int l) {
    for (int it = blockIdx.x; it < 512; it += gridDim.x) conv_item(p, lds, l, it < 256, it & 255, 1);
}

#ifndef PH_MASK
#define PH_MASK 0xffff
#endif
#define EN(x) (((PH_MASK) >> (x)) & 1)
#ifndef REP_MASK
#define REP_MASK 0
#endif
#define RP(x) (((REP_MASK) >> (x)) & 1)
__device__ __forceinline__ int ph_cat(int s) { return s == 0 ? 1 : s == 1 ? 2 : s == 2 ? 3 : s == 3 ? 1 : s == 4 ? 4 : s == 5 ? 5 : s == 6 ? 6 : s == 7 ? 7 : s == 8 ? 8 : s == 9 ? 1 : s == 10 ? 2 : 3; }
template <class Epi>
__device__ __forceinline__ void run_gemm(LAS unsigned char* lds, const bf16_t* A, const bf16_t* Bt, int N, int K, const Epi& E) {
    pg8::Gemm g{A, Bt, MTOK, N, K}; pg8::StaticOrder S; S.init(MTOK, N, (int)gridDim.x, (int)blockIdx.x);
    pg8::gemm_phase<Epi, pg8::StaticOrder>(lds, g, S, E);
}

__global__ void __launch_bounds__(NTHR) mega(Params p) {
    extern __shared__ __attribute__((aligned(16))) unsigned char smem[];
    LAS unsigned char* lds = (LAS unsigned char*)smem;
    cg::grid_group grid = cg::this_grid();
    volatile LAS unsigned* bst = (volatile LAS unsigned*)(lds + 131072);
    if (threadIdx.x == 0) { bst[0] = 0u; bst[1] = 0u; }
    __syncthreads();
    XcdBarrier xbar = xcd_barrier_post((unsigned*)(p.ws + WS_BAR), bst);
    float* X = p.out; const float* mod = (const float*)(p.ws + WS_MOD);
    bf16_t* AB = (bf16_t*)(p.ws + WS_ABUF);
    for (int ph = p.ph_lo; ph < p.ph_hi; ++ph) {
      const int cat_ = ph == 0 ? 0 : (((ph - 1) % 12 == 0 && ph == 1) ? 9 : ph_cat((ph - 1) % 12));
      for (int rep_ = 0; rep_ < 1 + RP(cat_); ++rep_) {
        if (ph == 0) { if (EN(0)) ph_prep(p, lds); }
        else {
            const int l = (ph - 1) / 12, s = (ph - 1) % 12;
            const float* xp = (l == 0 && s < 3) ? p.in[0] : X; const float* xs = (l == 0 && s < 3) ? p.in[1] : X + (size_t)MPR * 1024;
            const float* ml = mod + (size_t)l * 5 * 9216;
            switch (s) {
            case 0: if (EN(1)) { if (l == 0) { for (int it = blockIdx.x; it < 512; it += gridDim.x) filter_item(p, lds, it); } }
                    if (EN(2)) ph_norm(p, l, 0, xp, xs); break;
            case 1: if (EN(3)) run_gemm(lds, AB, (const bf16_t*)(p.ws + WS_WGU + (size_t)(l * 2) * SZ_WGU), 5632, 1024, EpiSwiglu{(bf16_t*)(p.ws + WS_ACT)}); break;
            case 2: if (EN(4)) run_gemm(lds, (const bf16_t*)(p.ws + WS_ACT), (const bf16_t*)(p.ws + WS_WD + (size_t)(l * 2) * SZ_WD), 1024, 2816, EpiResid{xp, xs, X, ml + 2 * 1024, 0.5f}); break;
            case 3: if (EN(2)) ph_norm(p, l, 1, X, X + (size_t)MPR * 1024); break;
            case 4: if (EN(5)) run_gemm(lds, AB, (const bf16_t*)(p.ws + WS_WIN + (size_t)l * SZ_WIN), 1792, 1024, EpiStore{(bf16_t*)(p.ws + WS_U), 1792}); break;
            case 5: if (EN(6)) ph_mixprep(p, lds, l); break;
            case 6: if (EN(7)) ph_attn_conv1(p, lds, l); break;
            case 7: if (EN(8)) ph_conv2(p, lds, l); break;
            case 8: if (EN(4)) run_gemm(lds, AB, (const bf16_t*)(p.ws + WS_WOUT + (size_t)l * SZ_WOUT), 1024, 1024, EpiResid{X, X + (size_t)MPR * 1024, X, ml + 5 * 1024, 1.0f}); break;
            case 9: if (EN(2)) ph_norm(p, l, 2, X, X + (size_t)MPR * 1024); break;
            case 10: if (EN(3)) run_gemm(lds, AB, (const bf16_t*)(p.ws + WS_WGU + (size_t)(l * 2 + 1) * SZ_WGU), 5632, 1024, EpiSwiglu{(bf16_t*)(p.ws + WS_ACT)}); break;
            default: if (EN(4)) run_gemm(lds, (const bf16_t*)(p.ws + WS_ACT), (const bf16_t*)(p.ws + WS_WD + (size_t)(l * 2 + 1) * SZ_WD), 1024, 2816, EpiResid{X, X + (size_t)MPR * 1024, X, ml + 8 * 1024, 0.5f}); break;
            }
        }
      }
        if (ph + 1 < p.ph_hi) { if (ph == 0) grid.sync(); else xcd_barrier(xbar); if (RP(15)) xcd_barrier(xbar); }
    }
}

#ifndef MK_MULTI
#define MK_MULTI 0
#endif
extern "C" void kernel_launch(void* const* d_in, const int* in_sizes, int n_in, void* d_out, int out_size, void* d_ws, size_t ws_size, hipStream_t stream) {
    static int grid = 0;
    if (grid == 0) {
        if (n_in != 30 || ws_size < WS_END2) { fprintf(stderr, "kernel_launch: bad arguments: n_in %d ws %zu (need %zu)\n", n_in, ws_size, (size_t)WS_END2); grid = -1; return; }
        int dev = 0, cus = 0, per_cu = 0;
        hipGetDevice(&dev); hipDeviceGetAttribute(&cus, hipDeviceAttributeMultiprocessorCount, dev);
        if (hipFuncSetAttribute((const void*)mega, hipFuncAttributeMaxDynamicSharedMemorySize, LDS_BYTES) != hipSuccess) { fprintf(stderr, "kernel_launch: hipFuncSetAttribute failed\n"); grid = -1; return; }
        if (hipOccupancyMaxActiveBlocksPerMultiprocessor(&per_cu, (const void*)mega, NTHR, LDS_BYTES) != hipSuccess || per_cu < 1) { fprintf(stderr, "kernel_launch: occupancy query says %d\n", per_cu); per_cu = 1; }
        (void)hipGetLastError();
        grid = cus * 1;
    }
    if (grid < 0) return;
    Params prm{};
    for (int i = 0; i < 30; ++i) prm.in[i] = (const float*)d_in[i];
    prm.out = (float*)d_out; prm.ws = (unsigned char*)d_ws;
#if MK_MULTI
    for (int ph = 0; ph < NPH; ++ph) { prm.ph_lo = ph; prm.ph_hi = ph + 1; hipLaunchKernelGGL(mega, dim3(grid), dim3(NTHR), LDS_BYTES, stream, prm); }
#else
    prm.ph_lo = 0; prm.ph_hi = NPH;
    if (hipMemsetAsync((unsigned char*)d_ws + WS_BAR, 0, (size_t)XCD_BAR_WORDS * 4, stream) != hipSuccess) { fprintf(stderr, "kernel_launch: memset of the barrier words failed\n"); return; }
    void* args[] = {&prm};
    hipError_t e = hipLaunchCooperativeKernel((const void*)mega, dim3(grid), dim3(NTHR), args, LDS_BYTES, stream);
    if (e != hipSuccess) fprintf(stderr, "cooperative launch failed: %s (grid %d)\n", hipGetErrorString(e), grid);
#endif
}
```

```cpp
#include <hip/hip_runtime.h>
#include <hip/hip_cooperative_groups.h>
#include <cstdio>
namespace cg = cooperative_groups;
namespace pg8 {
#define PG8_LAS __attribute__((address_space(3)))
typedef unsigned short bf16_t;
typedef short bf16x8 __attribute__((ext_vector_type(8)));
typedef float f32x4 __attribute__((ext_vector_type(4)));
typedef unsigned u32x4 __attribute__((ext_vector_type(4)));
constexpr int BM = 256, BK = 64, HALF = 128, HTB = HALF * BK * 2  , STAGE_BYTES = 8 * HTB, NXCD = 8, WGM = 8;
__host__ __device__ __forceinline__ int lds_byte(int r, int c) { const int st = (r >> 4) * 2 + (c >> 5), rr = r & 15, cc = c & 31, ob = rr * 64 + cc * 2; return st * 1024 + (ob ^ (((ob >> 9) & 1) << 5)); }
__host__ __device__ __forceinline__ void stage_rc(int b, int& R, int& C) { const int st = b / 1024, sb = b % 1024, swz = sb ^ (((sb >> 9) & 1) << 5); R = (st >> 1) * 16 + swz / 64; C = (st & 1) * 32 + (swz % 64) / 2; }
__host__ __device__ __forceinline__ int perm32(int rho) { const int n = rho >> 4, i = rho & 15; return 8 * (i >> 2) + 4 * n + (i & 3); }

struct Unit { int pm, pn; };
struct Gemm { const bf16_t* A; const bf16_t* Bt; int M, N, K; };
struct StaticOrder {
    int nM, nN, nwg, G, c;
    __host__ __device__ void init(int M, int N, int G_, int c_) { nM = M / BM; nN = N / BM; nwg = nM * nN; G = G_; c = c_; }
    __host__ __device__ bool next(int i, Unit& u) const {
        const long L = (long)i * G + c; if (L >= nwg) return false;
        int wgid = (int)L; { const int q = nwg / NXCD, r = nwg % NXCD, xcd = wgid % NXCD, off = wgid / NXCD; wgid = (xcd < r ? xcd * (q + 1) : r * (q + 1) + (xcd - r) * q) + off; }
        const int nig = WGM * nN, gid = wgid / nig, fm = gid * WGM, gsz = (nM - fm) < WGM ? (nM - fm) : WGM;
        u.pm = fm + ((wgid % nig) % gsz); u.pn = (wgid % nig) / gsz; return true;
    }
    __device__ __forceinline__ void a_ready(const Unit&) const {}
    __device__ __forceinline__ void done(const Unit&) const {}
};
__device__ __forceinline__ unsigned cvt_pk_bf16(float lo, float hi) { unsigned r; asm volatile("v_cvt_pk_bf16_f32 %0, %1, %2" : "=v"(r) : "v"(lo), "v"(hi)); return r; }
template <class Epi, class Sched>
__device__ __forceinline__ void gemm_phase(PG8_LAS unsigned char* lds, const Gemm g, const Sched& S, const Epi& E) {
    int tid_ = threadIdx.x; asm volatile("" : "+v"(tid_)); const int tid = tid_, wid = __builtin_amdgcn_readfirstlane(tid >> 6), lane = tid & 63, wr = wid >> 2, wc = wid & 3, fr = lane & 15, fq = lane >> 4;
    const int K = g.K, nt = K / BK;
#define PG8_STAMP() do {} while (0)
    unsigned voffA[2], voffB[2];
#pragma unroll
    for (int i = 0; i < 2; ++i) { int R, C; stage_rc(tid * 16 + i * 8192, R, C); const int Rb = Epi::PERM ? ((R & ~31) + perm32(R & 31)) : R;
        voffA[i] = (unsigned)(R * K + C) * 2u; voffB[i] = (unsigned)(Rb * K + C) * 2u; }
    const size_t kstep = (size_t)(BK * 2);
    const size_t hstep = (size_t)HALF * K * 2;
    const size_t tstep = 2 * hstep;
    const unsigned ldsw = (unsigned)wid * 1024u;
    const int aoff = lds_byte(wr * 64 + fr, fq * 8), boff = lds_byte(wc * 32 + fr, fq * 8);
#define PG8_SA(b, h) (((b) * 2 + (h)) * HTB)
#define PG8_SB(b, h) ((4 + (b) * 2 + (h)) * HTB)
#define PG8_STAGE(bufoff, gbase, voff) do { _Pragma("unroll") for (int _i = 0; _i < 2; ++_i) \
        __builtin_amdgcn_global_load_lds((const unsigned*)((const char*)(gbase) + (voff)[_i]), (PG8_LAS unsigned*)(lds + (bufoff) + ldsw + _i * 8192), 16, 0, 0); } while (0)
#define PG8_LDA(dst, b, h) do { _Pragma("unroll") for (int m = 0; m < 4; ++m) _Pragma("unroll") for (int k = 0; k < 2; ++k) dst[m][k] = *(const PG8_LAS bf16x8*)(lds + PG8_SA(b, h) + aoff + m * 2048 + k * 1024); } while (0)
#define PG8_LDB(dst, b, h) do { _Pragma("unroll") for (int n = 0; n < 2; ++n) _Pragma("unroll") for (int k = 0; k < 2; ++k) dst[n][k] = *(const PG8_LAS bf16x8*)(lds + PG8_SB(b, h) + boff + n * 2048 + k * 1024); } while (0)
#define PG8_MMA(ai, bj, At, Bt) do { __builtin_amdgcn_s_setprio(1); _Pragma("unroll") for (int m = 0; m < 4; ++m) _Pragma("unroll") for (int n = 0; n < 2; ++n) _Pragma("unroll") for (int k = 0; k < 2; ++k) \
        acc[ai][bj][m][n] = __builtin_amdgcn_mfma_f32_16x16x32_bf16(Bt[n][k], At[m][k], acc[ai][bj][m][n], 0, 0, 0); __builtin_amdgcn_s_setprio(0); } while (0)
#define PG8_WAIT_V(n) asm volatile("s_waitcnt vmcnt(" #n ")" ::: "memory")
#define PG8_WAIT_L(n) asm volatile("s_waitcnt lgkmcnt(" #n ")" ::: "memory")
#define PG8_BAR __builtin_amdgcn_s_barrier()
#define PG8_SCHED __builtin_amdgcn_sched_barrier(0)
    Unit cur, nxt; int ui = 0;
    if (!S.next(0, cur)) return;
    f32x4 acc[2][2][4][2];
#pragma unroll
    for (int a = 0; a < 2; ++a)
#pragma unroll
        for (int b = 0; b < 2; ++b)
#pragma unroll
            for (int m = 0; m < 4; ++m)
#pragma unroll
                for (int n = 0; n < 2; ++n) acc[a][b][m][n] = (f32x4){0.f, 0.f, 0.f, 0.f};
    bf16x8 At[4][2], B0[2][2], B1[2][2];
    const char* cA = (const char*)g.A + (size_t)cur.pm * tstep; const char* cB = (const char*)g.Bt + (size_t)cur.pn * tstep;
    S.a_ready(cur);
    PG8_STAGE(PG8_SB(0, 0), cB, voffB); PG8_STAGE(PG8_SA(0, 0), cA, voffA); PG8_STAGE(PG8_SB(0, 1), cB + hstep, voffB); PG8_STAGE(PG8_SA(0, 1), cA + hstep, voffA);
    if (wr == 1) PG8_BAR;
    PG8_WAIT_V(4); PG8_BAR;
    PG8_STAGE(PG8_SB(1, 0), cB + kstep, voffB); PG8_STAGE(PG8_SA(1, 0), cA + kstep, voffA); PG8_STAGE(PG8_SB(1, 1), cB + hstep + kstep, voffB);
    PG8_WAIT_V(6); PG8_BAR;
    PG8_STAMP();
    for (;;) {
        const bool has_next = S.next(ui + 1, nxt);
        const char* nA = has_next ? (const char*)g.A + (size_t)nxt.pm * tstep : cA; const char* nB = has_next ? (const char*)g.Bt + (size_t)nxt.pn * tstep : cB;
        for (int t = 0; t < nt; t += 2) {
            const bool last = (t == nt - 2);
            const char* a1 = cA + (size_t)(t + 1) * kstep;
            const char* a2 = last ? nA : cA + (size_t)(t + 2) * kstep; const char* b2 = last ? nB : cB + (size_t)(t + 2) * kstep;
            const char* a3 = a2 + kstep; const char* b3 = b2 + kstep;
            if (last && has_next) S.a_ready(nxt);
            PG8_LDB(B0, 0, 0); PG8_SCHED; PG8_LDA(At, 0, 0); PG8_STAGE(PG8_SA(1, 1), a1 + hstep, voffA);
            PG8_WAIT_L(8); PG8_BAR; PG8_WAIT_L(0); PG8_MMA(0, 0, At, B0); PG8_BAR; PG8_SCHED;
            PG8_LDB(B1, 0, 1); PG8_STAGE(PG8_SB(0, 0), b2, voffB);
            PG8_BAR; PG8_WAIT_L(0); PG8_MMA(0, 1, At, B1); PG8_BAR;
            PG8_LDA(At, 0, 1); PG8_STAGE(PG8_SA(0, 0), a2, voffA);
            PG8_BAR; PG8_WAIT_L(0); PG8_MMA(1, 0, At, B0); PG8_BAR; PG8_SCHED;
            PG8_STAGE(PG8_SB(0, 1), b2 + hstep, voffB);
            PG8_WAIT_V(6); PG8_BAR; PG8_MMA(1, 1, At, B1); PG8_BAR;
            PG8_LDB(B0, 1, 0); PG8_SCHED; PG8_LDA(At, 1, 0); PG8_STAGE(PG8_SA(0, 1), a2 + hstep, voffA);
            PG8_WAIT_L(8); PG8_BAR; PG8_WAIT_L(0); PG8_MMA(0, 0, At, B0); PG8_BAR; PG8_SCHED;
            PG8_LDB(B1, 1, 1); PG8_STAGE(PG8_SB(1, 0), b3, voffB);
            PG8_BAR; PG8_WAIT_L(0); PG8_MMA(0, 1, At, B1); PG8_BAR;
            PG8_LDA(At, 1, 1); PG8_STAGE(PG8_SA(1, 0), a3, voffA);
            PG8_BAR; PG8_WAIT_L(0); PG8_MMA(1, 0, At, B0); PG8_BAR; PG8_SCHED;
            PG8_STAGE(PG8_SB(1, 1), b3 + hstep, voffB);
            PG8_WAIT_V(6); PG8_BAR; PG8_MMA(1, 1, At, B1); PG8_BAR;
        }
        PG8_STAMP();
        if constexpr (!Epi::AFTER_DRAIN) { E(acc, cur, wr, wc, fr, fq); S.done(cur); }
        PG8_STAMP();
        if (!has_next) break;
#pragma unroll
        for (int a = 0; a < 2; ++a)
#pragma unroll
            for (int b = 0; b < 2; ++b)
#pragma unroll
                for (int m = 0; m < 4; ++m)
#pragma unroll
                    for (int n = 0; n < 2; ++n) acc[a][b][m][n] = (f32x4){0.f, 0.f, 0.f, 0.f};
        cur = nxt; cA = nA; cB = nB; ++ui;
    }
    PG8_WAIT_V(0);
    if (wr == 0) PG8_BAR;
    PG8_BAR;
    if constexpr (Epi::AFTER_DRAIN) { E.fused(acc, cur, wr, wc, fr, fq, lds, wid, lane); S.done(cur); }
    PG8_STAMP();
#undef PG8_SA
#undef PG8_SB
#undef PG8_STAGE
#undef PG8_LDA
#undef PG8_LDB
#undef PG8_MMA
#undef PG8_WAIT_V
#undef PG8_WAIT_L
#undef PG8_BAR
#undef PG8_SCHED
}
}


#define XB_SPIN_CAP (1u << 18)

#define XB_TMO      128
#define XB_XCNT(j)  (256  + 64 * (j))
#define XB_XSUB(j)  (1280 + 64 * (j))
#define XB_XGEN(j)  (2304 + 64 * (j))
#define XB_TOP      3328
#define XB_TOPGEN   3392
#define XCD_BAR_WORDS 3456
#define LAS __attribute__((address_space(3)))

__device__ __forceinline__ unsigned xb_ld(unsigned* p)              { return __hip_atomic_load(p, __ATOMIC_RELAXED, __HIP_MEMORY_SCOPE_AGENT); }
__device__ __forceinline__ unsigned xb_add(unsigned* p, unsigned v) { return __hip_atomic_fetch_add(p, v, __ATOMIC_RELAXED, __HIP_MEMORY_SCOPE_AGENT); }
__device__ __forceinline__ unsigned xb_xcc_id() { return (unsigned)__builtin_amdgcn_s_getreg((3 << 11) | 20) & 0xFu; }
#define XB_SPIN(cond, bar) do { unsigned _sp = 0; while (cond) { __builtin_amdgcn_s_sleep(1); \
    if ((++_sp & 255u) == 0u) { if (xb_ld(&(bar)[XB_TMO])) break; if (_sp > XB_SPIN_CAP) { atomicAdd(&(bar)[XB_TMO], 1u); break; } } } } while (0)
struct XcdBarrier {
    unsigned* bar; unsigned x;
    volatile LAS unsigned* st;
};

__device__ __forceinline__ XcdBarrier xcd_barrier_post(unsigned* bar, volatile LAS unsigned* st) {
    XcdBarrier b; b.bar = bar; b.x = xb_xcc_id(); b.st = st;
    if (threadIdx.x == 0) (void)xb_add(&bar[XB_XCNT(b.x)], 1u);
    return b;
}
__device__ __forceinline__ void xcd_barrier_complete(unsigned* bar, unsigned x, unsigned& nloc, unsigned& nx) {
    const unsigned G = gridDim.x * gridDim.y * gridDim.z;
    unsigned sum, cnt, mine, sp = 0u;
    for (;;) {
        sum = 0u; cnt = 0u; mine = 0u;
#pragma unroll
        for (unsigned j = 0; j < 16; ++j) { const unsigned c = xb_ld(&bar[XB_XCNT(j)]); sum += c; cnt += (c > 0u) ? 1u : 0u; mine = (j == x) ? c : mine; }
        if (sum == G) break;
        __builtin_amdgcn_s_sleep(1);
        if ((++sp & 255u) == 0u) { if (xb_ld(&bar[XB_TMO])) break; if (sp > XB_SPIN_CAP) { atomicAdd(&bar[XB_TMO], 1u); break; } }
    }
    nloc = mine > 0u ? mine : 1u; nx = cnt > 0u ? cnt : 1u;
}

__device__ __forceinline__ void xcd_barrier(const XcdBarrier& b) {
    asm volatile("s_waitcnt vmcnt(0)" ::: "memory");
    __syncthreads();
    if (threadIdx.x == 0) {
        unsigned* bar = b.bar;
        __builtin_amdgcn_s_waitcnt(0);
        unsigned nloc = b.st[0], nx = b.st[1];
        if (nloc == 0u) { xcd_barrier_complete(bar, b.x, nloc, nx); b.st[0] = nloc; b.st[1] = nx; }
        const unsigned old = xb_add(&bar[XB_XSUB(b.x)], 1u);
        const unsigned gen = old / nloc;
        if (old + 1u == (gen + 1u) * nloc) {
            __builtin_amdgcn_fence(__ATOMIC_RELEASE, "agent");
            asm volatile("s_waitcnt vmcnt(0)" ::: "memory");
            const unsigned og = xb_add(&bar[XB_TOP], 1u);
            const unsigned tg = og / nx;
            if (og + 1u == (tg + 1u) * nx) xb_add(&bar[XB_TOPGEN], 1u);
            else XB_SPIN(xb_ld(&bar[XB_TOPGEN]) == tg, bar);
            __builtin_amdgcn_fence(__ATOMIC_ACQUIRE, "agent");
            xb_add(&bar[XB_XGEN(b.x)], 1u);
            asm volatile("s_waitcnt vmcnt(0)" ::: "memory");
        } else {
            XB_SPIN(xb_ld(&bar[XB_XGEN(b.x)]) == gen, bar);
            __builtin_amdgcn_fence(__ATOMIC_ACQUIRE, "agent");
            asm volatile("s_waitcnt vmcnt(0)" ::: "memory");
        }
    }
    __syncthreads();
}


#define LAS __attribute__((address_space(3)))
typedef unsigned short bf16_t;
typedef short bf16x8 __attribute__((ext_vector_type(8)));
typedef float f32x4 __attribute__((ext_vector_type(4)));
typedef float f32x16 __attribute__((ext_vector_type(16)));
typedef unsigned u32x4 __attribute__((ext_vector_type(4)));
typedef unsigned u32x2 __attribute__((ext_vector_type(2)));

constexpr int MTOK = 20480, MPR = 4096;
constexpr int NPH = 25;
constexpr int LDS_BYTES = 131072 + 16;
constexpr int NTHR = 512;

constexpr size_t SZ_WGU = (size_t)5632 * 1024 * 2, SZ_WD = (size_t)1024 * 2816 * 2, SZ_WIN = (size_t)1792 * 1024 * 2, SZ_WOUT = (size_t)1024 * 1024 * 2;
constexpr size_t WS_WGU = 0;
constexpr size_t WS_WD = WS_WGU + 4 * SZ_WGU;
constexpr size_t WS_WIN = WS_WD + 4 * SZ_WD;
constexpr size_t WS_WOUT = WS_WIN + 2 * SZ_WIN;
constexpr size_t WS_MOD = WS_WOUT + 2 * SZ_WOUT;
constexpr size_t WS_ABUF = WS_MOD + (size_t)2 * 5 * 9216 * 4;
constexpr size_t WS_R = WS_ABUF + (size_t)MTOK * 1024 * 2;
constexpr size_t WS_ACT = WS_R;
constexpr size_t WS_U = WS_R;
constexpr size_t WS_QB = WS_U + (size_t)MTOK * 1792 * 2;
constexpr size_t WS_KB = WS_QB + (size_t)MTOK * 512 * 2;
constexpr size_t WS_VT = WS_KB + (size_t)MTOK * 128 * 2;
constexpr size_t WS_Z1 = WS_VT + (size_t)MTOK * 128 * 2;
constexpr size_t WS_HV = WS_R + (size_t)MTOK * 2816 * 2;
constexpr size_t WS_X1 = WS_HV + (size_t)MTOK * 256 * 2;
constexpr size_t WS_X2 = WS_X1 + (size_t)MTOK * 256 * 2;
constexpr size_t WS_FILT = WS_X2 + (size_t)MTOK * 256 * 2;
constexpr size_t SZ_FILT_S = (size_t)2 * 256 * 8192 * 2, SZ_FILT_P = (size_t)2 * 256 * 512 * 2, SZ_FILT_L = SZ_FILT_S + SZ_FILT_P;
constexpr size_t WS_FSC = WS_FILT + 2 * SZ_FILT_L;
constexpr size_t WS_H2 = WS_FSC + (size_t)2 * 2 * 2 * 256 * 4;
constexpr size_t WS_KC = WS_H2 + (size_t)2 * 4352 * 64 * 4;
constexpr size_t WS_VCT = WS_KC + (size_t)2 * 4 * 256 * 128 * 2;
constexpr size_t WS_END = WS_VCT + (size_t)2 * 4 * 256 * 128 * 2;
constexpr size_t WS_BAR = WS_END;
constexpr size_t WS_END2 = WS_BAR + (size_t)XCD_BAR_WORDS * 4;
static_assert(WS_Z1 + (size_t)MTOK * 256 * 2 <= WS_HV, "alias region overflow");

constexpr size_t OUT_K = (size_t)MTOK * 1024, OUT_V = OUT_K + (size_t)16 * 2 * 256 * 128;

struct Params { const float* in[30]; float* out; unsigned char* ws; int ph_lo, ph_hi; };

__device__ __forceinline__ int otid() { int t = threadIdx.x; asm volatile("" : "+v"(t)); return t; }
__device__ __forceinline__ float bf2f(bf16_t b) { return __uint_as_float(((unsigned)b) << 16); }
__device__ __forceinline__ float bflo(unsigned w) { return __uint_as_float(w << 16); }
__device__ __forceinline__ float bfhi(unsigned w) { return __uint_as_float(w & 0xffff0000u); }
__device__ __forceinline__ unsigned pk(float lo, float hi) { return pg8::cvt_pk_bf16(lo, hi); }
__device__ __forceinline__ bf16_t f2bf(float f) { return (bf16_t)(pk(f, 0.f) & 0xffffu); }
__device__ __forceinline__ void unpack8(const u32x4 w, float* x) { x[0] = bflo(w.x); x[1] = bfhi(w.x); x[2] = bflo(w.y); x[3] = bfhi(w.y); x[4] = bflo(w.z); x[5] = bfhi(w.z); x[6] = bflo(w.w); x[7] = bfhi(w.w); }
__device__ __forceinline__ u32x4 pack8(const float* x) { u32x4 w; w.x = pk(x[0], x[1]); w.y = pk(x[2], x[3]); w.z = pk(x[4], x[5]); w.w = pk(x[6], x[7]); return w; }

__device__ void mod_item(const Params& p, LAS unsigned char* lds, int it) {
    const int tid = otid(), l = it / 72, nt = it % 72;
    LAS float* sc = (LAS float*)lds;
    LAS float* red = (LAS float*)(lds + 20480);
    for (int i = tid; i < 5 * 1024; i += NTHR) { const int ci = i >> 10, k = i & 1023; const float v = ci == 0 ? p.in[5][k] : p.in[4][(ci - 1) * 1024 + k]; sc[i] = v / (1.f + expf(-v)); }
    __syncthreads();
    const int cq = tid & 31, kg = tid >> 5;
    const float* W = p.in[6] + (size_t)l * 1024 * 9216 + nt * 128 + cq * 4;
    f32x4 acc[5];
#pragma unroll
    for (int ci = 0; ci < 5; ++ci) acc[ci] = (f32x4){0.f, 0.f, 0.f, 0.f};
#pragma unroll 4
    for (int kk = 0; kk < 64; ++kk) { const int k = kg * 64 + kk; const f32x4 w = *(const f32x4*)(W + (size_t)k * 9216);
#pragma unroll
        for (int ci = 0; ci < 5; ++ci) acc[ci] += sc[ci * 1024 + k] * w; }
#pragma unroll
    for (int ci = 0; ci < 5; ++ci)
#pragma unroll
        for (int j = 0; j < 4; ++j) red[(kg * 5 + ci) * 128 + cq * 4 + j] = acc[ci][j];
    __syncthreads();
    float* mod = (float*)(p.ws + WS_MOD);
    for (int i = tid; i < 640; i += NTHR) { const int ci = i >> 7, n = i & 127; float s = 0.f;
#pragma unroll
        for (int g = 0; g < 16; ++g) s += red[(g * 5 + ci) * 128 + n];
        mod[(size_t)(l * 5 + ci) * 9216 + nt * 128 + n] = s + p.in[7][l * 9216 + nt * 128 + n]; }
    __syncthreads();
}

__device__ void h2_item(const Params& p, int idx) {
    const int tid = otid(), lane = tid & 63, wave = tid >> 6;
    const int rowid = idx * 8 + wave, l = rowid / 4352, rr = rowid % 4352, Lsel = rr < 256 ? 0 : 1, t = Lsel ? rr - 256 : rr, L = Lsel ? 4096 : 256;
    float zv = 0.f;
    { const float tl = (float)t / (float)(L - 1); const float w = 6.283185307179586f * (float)t / (float)L;
      if (lane == 0) zv = tl;
      else if (lane <= 16) { const float f = 1e-4f + (float)(lane - 1) * ((15.f - 1e-4f) / 15.f); zv = cosf(f * w); }
      else if (lane <= 32) { const float f = 1e-4f + (float)(lane - 17) * ((15.f - 1e-4f) / 15.f); zv = -sinf(f * w); } }
    const float* w1 = p.in[21] + l * 33 * 64; const float* w2 = p.in[23] + l * 4096; const float* fr = p.in[27] + l * 128;
    float a = 0.f;
    for (int e = 0; e < 33; ++e) a += __shfl(zv, e) * w1[e * 64 + lane];
    a = sinf(fr[lane] * (a + p.in[22][l * 64 + lane]));
    float b = 0.f;
    for (int i = 0; i < 64; ++i) b += __shfl(a, i) * w2[i * 64 + lane];
    b = sinf(fr[64 + lane] * (b + p.in[24][l * 64 + lane]));
    ((float*)(p.ws + WS_H2))[((size_t)l * 4352 + rr) * 64 + lane] = b;
}

__device__ void cache_item(const Params& p, int idx) {
    const int tid = otid();
    const bool isv = idx >= 64; const int base = (idx & 63) * 4096;
    bf16_t* dst = (bf16_t*)(p.ws + (isv ? WS_VCT : WS_KC)); const float* src = p.in[isv ? 3 : 2];
#pragma unroll
    for (int i = 0; i < 8; ++i) { const int o = base + i * 512 + tid; int l, b, s, e;
        if (!isv) { e = o & 127; s = (o >> 7) & 255; b = (o >> 15) & 3; l = o >> 17; }
        else { s = o & 255; e = (o >> 8) & 127; b = (o >> 15) & 3; l = o >> 17; }
        dst[o] = f2bf(src[((size_t)(b * 2 + l) * 256 + s) * 128 + e]); }
}

__device__ void transpose_item(const Params& p, LAS unsigned char* lds, int idx) {
    const int tid = otid();
    const int l = idx / 4928, rem = idx % 4928; const float* src; bf16_t* dst; int K, N, kt, nt, mode = 0;
    if (rem < 4224) { const int f = rem / 2112, r2 = rem % 2112, kind = r2 / 704, t = r2 % 704, lf = l * 2 + f;
        if (kind < 2) { src = p.in[9 + kind] + (size_t)lf * 1024 * 2816; K = 1024; N = 2816; kt = t / 44; nt = t % 44; dst = (bf16_t*)(p.ws + WS_WGU + lf * SZ_WGU); mode = 1 + kind; }
        else { src = p.in[11] + (size_t)lf * 2816 * 1024; K = 2816; N = 1024; kt = t / 16; nt = t % 16; dst = (bf16_t*)(p.ws + WS_WD + lf * SZ_WD); } }
    else if (rem < 4672) { const int t = rem - 4224; src = p.in[12] + (size_t)l * 1024 * 1792; K = 1024; N = 1792; kt = t / 28; nt = t % 28; dst = (bf16_t*)(p.ws + WS_WIN + l * SZ_WIN); }
    else { const int t = rem - 4672; src = p.in[13] + (size_t)l * 1024 * 1024; K = 1024; N = 1024; kt = t / 16; nt = t % 16; dst = (bf16_t*)(p.ws + WS_WOUT + l * SZ_WOUT); }
    LAS float* T = (LAS float*)lds;
#pragma unroll
    for (int i = 0; i < 2; ++i) { const int e = tid + i * 512, kr = e >> 4, c4 = e & 15; const f32x4 v = *(const f32x4*)(src + (size_t)(kt * 64 + kr) * N + nt * 64 + c4 * 4);
#pragma unroll
        for (int j = 0; j < 4; ++j) T[kr * 65 + c4 * 4 + j] = v[j]; }
    __syncthreads();
    { const int n = tid >> 3, kc = tid & 7, ng = nt * 64 + n; const int drow = mode == 0 ? ng : ((ng >> 4) * 32 + (mode == 2 ? 16 : 0) + (ng & 15));
      float x[8];
#pragma unroll
      for (int j = 0; j < 8; ++j) x[j] = T[(kc * 8 + j) * 65 + n];
      *(u32x4*)(dst + (size_t)drow * K + kt * 64 + kc * 8) = pack8(x); }
    __syncthreads();
}

__device__ void ph_prep(const Params& p, LAS unsigned char* lds) {
    constexpr int N_MOD = 144, N_H2 = 1088, N_CACHE = 128, N_TR = 9856;
    for (int it = blockIdx.x; it < N_MOD + N_H2 + N_CACHE + N_TR; it += gridDim.x) {
        if (it < N_MOD) mod_item(p, lds, it);
        else if (it < N_MOD + N_H2) h2_item(p, it - N_MOD);
        else if (it < N_MOD + N_H2 + N_CACHE) cache_item(p, it - N_MOD - N_H2);
        else transpose_item(p, lds, it - N_MOD - N_H2 - N_CACHE);
    }
}

__device__ __forceinline__ bf16_t* filt_ptr(const Params& p, int l, int Lsel) { return (bf16_t*)(p.ws + WS_FILT + l * SZ_FILT_L + (Lsel ? 0 : SZ_FILT_S)); }

__device__ void filter_item(const Params& p, LAS unsigned char* lds, int fidx) {
    const int tid = otid(), lane = tid & 63, wave = tid >> 6;
    const int Lsel = fidx < 256 ? 1 : 0, f2 = fidx & 255, l = f2 >> 7, o = (f2 >> 6) & 1, cg4 = f2 & 63, L = Lsel ? 4096 : 256;
    LAS float* w3s = (LAS float*)lds;
    LAS float* red = (LAS float*)(lds + 2048);
    { const int ii = tid >> 3, q = tid & 7; w3s[tid] = p.in[25][(size_t)l * 64 * 1024 + ii * 1024 + (q >> 2) * 512 + o * 256 + cg4 * 4 + (q & 3)]; }
    __syncthreads();
    float b3v[8], del[4], asum[4];
#pragma unroll
    for (int q = 0; q < 8; ++q) b3v[q] = p.in[26][l * 1024 + (q >> 2) * 512 + o * 256 + cg4 * 4 + (q & 3)];
#pragma unroll
    for (int cc = 0; cc < 4; ++cc) { del[cc] = fabsf(p.in[28][l * 512 + o * 256 + cg4 * 4 + cc]); asum[cc] = 0.f; }
    const float* H = (const float*)(p.ws + WS_H2) + ((size_t)l * 4352 + (Lsel ? 256 : 0)) * 64;
    bf16_t* Gb = filt_ptr(p, l, Lsel) + (size_t)(o * 256 + cg4 * 4) * (2 * L);
#pragma unroll 1
    for (int t = tid; t < L; t += NTHR) {
        const float* hp = H + (size_t)t * 64;
        f32x4 a0 = (f32x4){0.f, 0.f, 0.f, 0.f}, a1 = a0;
        f32x4 cur = *(const f32x4*)hp;
#pragma unroll 1
        for (int i = 0; i < 16; ++i) {
            const f32x4 nxt = *(const f32x4*)(hp + ((i + 1) & 15) * 4);
            const LAS float* wp = w3s + i * 32;
#pragma unroll
            for (int j = 0; j < 4; ++j) { const f32x4 wa = *(const LAS f32x4*)(wp + j * 8), wb = *(const LAS f32x4*)(wp + j * 8 + 4); a0 += cur[j] * wa; a1 += cur[j] * wb; }
            cur = nxt;
        }
        const float tl = (float)t / (float)(L - 1);
#pragma unroll
        for (int cc = 0; cc < 4; ++cc) { const float dec = expf(-tl * del[cc]) + 0.05f; const float kf = (a0[cc] + b3v[cc]) * dec, kb = (a1[cc] + b3v[4 + cc]) * dec;
            Gb[(size_t)cc * 2 * L + (L - t)] = f2bf(kf); asum[cc] += fabsf(kf);
            if (t >= 1) { Gb[(size_t)cc * 2 * L + L + t] = f2bf(kb); asum[cc] += fabsf(kb); } }
    }
    if (tid < 4) Gb[(size_t)tid * 2 * L] = 0;
#pragma unroll
    for (int cc = 0; cc < 4; ++cc) { float v = asum[cc];
#pragma unroll
        for (int off = 32; off >= 1; off >>= 1) v += __shfl_xor(v, off);
        if (lane == 0) red[wave * 4 + cc] = v; }
    __syncthreads();
    if (tid < 4) { float s = 0.f;
#pragma unroll
        for (int w = 0; w < 8; ++w) s += red[w * 4 + tid];
        ((float*)(p.ws + WS_FSC))[((l * 2 + Lsel) * 2 + o) * 256 + cg4 * 4 + tid] = 1.0f / (s + 1e-6f); }
    __syncthreads();
}

__device__ void ph_norm(const Params& p, int l, int ni, const float* xp, const float* xs) {
    const int tid = otid(), lane = tid & 63, wave = tid >> 6;
    const float* nw = p.in[8] + (l * 3 + ni) * 1024; const float* mod = (const float*)(p.ws + WS_MOD) + (size_t)l * 5 * 9216;
    bf16_t* ab = (bf16_t*)(p.ws + WS_ABUF);
    for (int row = blockIdx.x * 8 + wave; row < MTOK; row += gridDim.x * 8) {
        const float* src = row < MPR ? xp + (size_t)row * 1024 : xs + (size_t)(row - MPR) * 1024; const int ci = row < MPR ? 0 : 1 + ((row - MPR) >> 12);
        f32x4 v[4]; float ss = 0.f;
#pragma unroll
        for (int i = 0; i < 4; ++i) { v[i] = *(const f32x4*)(src + i * 256 + lane * 4); ss += v[i][0] * v[i][0] + v[i][1] * v[i][1] + v[i][2] * v[i][2] + v[i][3] * v[i][3]; }
#pragma unroll
        for (int off = 32; off >= 1; off >>= 1) ss += __shfl_xor(ss, off);
        const float rstd = rsqrtf(ss * (1.0f / 1024.0f) + 1e-6f);
        const float* msh = mod + (size_t)ci * 9216 + (3 * ni) * 1024; const float* msc = msh + 1024;
#pragma unroll
        for (int i = 0; i < 4; ++i) { const int col = i * 256 + lane * 4; const f32x4 g = *(const f32x4*)(nw + col), sc = *(const f32x4*)(msc + col), sh = *(const f32x4*)(msh + col);
            const f32x4 y = v[i] * rstd * g * (1.0f + sc) + sh; u32x2 w; w.x = pk(y[0], y[1]); w.y = pk(y[2], y[3]);
            *(u32x2*)(ab + (size_t)row * 1024 + col) = w; }
    }
}

struct EpiSwiglu {
    static constexpr bool PERM = false, AFTER_DRAIN = false;
    bf16_t* act;
    __device__ __forceinline__ void operator()(const f32x4 (&acc)[2][2][4][2], const pg8::Unit& u, int wr, int wc, int fr, int fq) const {
        const int row0 = u.pm * 256 + wr * 64 + fr, col0 = u.pn * 128 + wc * 16 + 4 * fq;
#pragma unroll
        for (int ai = 0; ai < 2; ++ai)
#pragma unroll
            for (int m = 0; m < 4; ++m) { bf16_t* rowp = act + (size_t)(row0 + ai * 128 + m * 16) * 2816 + col0;
#pragma unroll
                for (int bj = 0; bj < 2; ++bj) { const f32x4 g = acc[ai][bj][m][0], uu = acc[ai][bj][m][1]; float o[4];
#pragma unroll
                    for (int j = 0; j < 4; ++j) o[j] = g[j] / (1.0f + __expf(-g[j])) * uu[j];
                    u32x2 w; w.x = pk(o[0], o[1]); w.y = pk(o[2], o[3]); *(u32x2*)(rowp + bj * 64) = w; } }
    }
};
struct EpiResid {
    static constexpr bool PERM = false, AFTER_DRAIN = false;
    const float* xp; const float* xs; float* out; const float* gate; float coef;
    __device__ __forceinline__ void operator()(const f32x4 (&acc)[2][2][4][2], const pg8::Unit& u, int wr, int wc, int fr, int fq) const {
        const int row0 = u.pm * 256 + wr * 64 + fr, col0 = u.pn * 256 + wc * 32 + 4 * fq; const int ci = u.pm < 16 ? 0 : 1 + ((u.pm - 16) >> 4);
        const float* gp = gate + (size_t)ci * 9216 + col0; f32x4 gv[2][2];
#pragma unroll
        for (int bj = 0; bj < 2; ++bj)
#pragma unroll
            for (int n = 0; n < 2; ++n) gv[bj][n] = *(const f32x4*)(gp + bj * 128 + n * 16) * coef;
#pragma unroll
        for (int ai = 0; ai < 2; ++ai)
#pragma unroll
            for (int m = 0; m < 4; ++m) { const int r = row0 + ai * 128 + m * 16; const float* src = (r < MPR ? xp + (size_t)r * 1024 : xs + (size_t)(r - MPR) * 1024) + col0; float* dst = out + (size_t)r * 1024 + col0;
#pragma unroll
                for (int bj = 0; bj < 2; ++bj)
#pragma unroll
                    for (int n = 0; n < 2; ++n) { const f32x4 x = *(const f32x4*)(src + bj * 128 + n * 16); *(f32x4*)(dst + bj * 128 + n * 16) = x + gv[bj][n] * acc[ai][bj][m][n]; }
                asm volatile("" ::: "memory"); }
    }
};
struct EpiStore {
    static constexpr bool PERM = false, AFTER_DRAIN = false;
    bf16_t* O; int ldc;
    __device__ __forceinline__ void operator()(const f32x4 (&acc)[2][2][4][2], const pg8::Unit& u, int wr, int wc, int fr, int fq) const {
        const int row0 = u.pm * 256 + wr * 64 + fr, col0 = u.pn * 256 + wc * 32 + 4 * fq;
#pragma unroll
        for (int ai = 0; ai < 2; ++ai)
#pragma unroll
            for (int m = 0; m < 4; ++m) { bf16_t* rowp = O + (size_t)(row0 + ai * 128 + m * 16) * ldc + col0;
#pragma unroll
                for (int bj = 0; bj < 2; ++bj)
#pragma unroll
                    for (int n = 0; n < 2; ++n) { const f32x4 v = acc[ai][bj][m][n]; u32x2 w; w.x = pk(v[0], v[1]); w.y = pk(v[2], v[3]); *(u32x2*)(rowp + bj * 128 + n * 16) = w; } }
    }
};

__device__ __forceinline__ void tile_info(int row0, int& rowbase, int& L, int& s0) {
    if (row0 < MPR) { rowbase = row0 & ~255; L = 256; s0 = row0 & 255; } else { const int r = row0 - MPR; rowbase = MPR + (r & ~4095); L = 4096; s0 = r & 4095; }
}

__device__ void pool_item(const Params& p, LAS unsigned char* lds, int l, int tile, int g) {
    const int tid = otid(); int rowbase, L, s0; tile_info(tile * 64, rowbase, L, s0);
    const bf16_t* U = (const bf16_t*)(p.ws + WS_U);
    LAS float* dl = (LAS float*)lds;
    LAS float* wl = (LAS float*)(lds + 64 * 65 * 4);
    { const float* W = p.in[14] + (size_t)(l * 4 + g) * 4096;
#pragma unroll
      for (int i = 0; i < 2; ++i) { const int e = tid + i * 512; *(LAS f32x4*)(wl + e * 4) = *(const f32x4*)(W + e * 4); } }
    { const int t = tid >> 3, cs = tid & 7, s = s0 + t, half = 1 << g;
      const int lo = max(s - half, 0), hi = min(s + half, L);
      float sum[8], x[8];
#pragma unroll
      for (int j = 0; j < 8; ++j) sum[j] = 0.f;
      for (int sp = lo; sp < hi; ++sp) { const u32x4 w = *(const u32x4*)(U + (size_t)(rowbase + sp) * 1792 + g * 64 + cs * 8); unpack8(w, x);
#pragma unroll
          for (int j = 0; j < 8; ++j) sum[j] += x[j]; }
      const u32x4 w = *(const u32x4*)(U + (size_t)(rowbase + s) * 1792 + g * 64 + cs * 8); unpack8(w, x);
      const float inv = 1.0f / (float)(hi - lo);
#pragma unroll
      for (int j = 0; j < 8; ++j) dl[t * 65 + cs * 8 + j] = sum[j] * inv - x[j]; }
    __syncthreads();
    { const int t = tid >> 3, dq = tid & 7; float o[8];
#pragma unroll
      for (int j = 0; j < 8; ++j) o[j] = 0.f;
#pragma unroll 8
      for (int c = 0; c < 64; ++c) { const float d = dl[t * 65 + c]; const f32x4 wa = *(const LAS f32x4*)(wl + c * 64 + dq * 8), wb = *(const LAS f32x4*)(wl + c * 64 + dq * 8 + 4);
#pragma unroll
          for (int j = 0; j < 4; ++j) { o[j] += d * wa[j]; o[4 + j] += d * wb[j]; } }
      const float* scl = p.in[15] + l * 256 + g * 64 + dq * 8;
#pragma unroll
      for (int j = 0; j < 8; ++j) o[j] *= scl[j];
      *(u32x4*)((bf16_t*)(p.ws + WS_ABUF) + (size_t)(tile * 64 + t) * 1024 + g * 64 + dq * 8) = pack8(o); }
    __syncthreads();
}

__device__ void qk_item(const Params& p, int l, int tile) {
    const int tid = otid(); int rowbase, L, s0; tile_info(tile * 64, rowbase, L, s0);
    const bf16_t* U = (const bf16_t*)(p.ws + WS_U); const bool lat = L == 4096;
    bf16_t* QB = (bf16_t*)(p.ws + WS_QB); bf16_t* KB = (bf16_t*)(p.ws + WS_KB);
    for (int pass = 0; pass < 10; ++pass) {
        const int idx = pass * 512 + tid, e = idx & 7, hh = (idx % 80) >> 3, t = idx / 80, row = tile * 64 + t, s = s0 + t;
        const bool isq = hh < 8; const int colbase = isq ? 256 + hh * 64 : 768 + (hh - 8) * 64;
        float x[8]; unpack8(*(const u32x4*)(U + (size_t)row * 1792 + colbase + e * 8), x);
        float ss = 0.f;
#pragma unroll
        for (int j = 0; j < 8; ++j) ss += x[j] * x[j];
        ss += __shfl_xor(ss, 1); ss += __shfl_xor(ss, 2); ss += __shfl_xor(ss, 4);
        const float rstd = rsqrtf(ss * (1.0f / 64.0f) + 1e-6f);
        const float* nw = p.in[isq ? 16 : 17] + l * 64 + e * 8;
#pragma unroll
        for (int j = 0; j < 8; ++j) x[j] = x[j] * rstd * nw[j];
        if (lat) {
            const float pos = (float)((e < 4) ? (s >> 6) : (s & 63));
#pragma unroll
            for (int j = 0; j < 8; ++j) { const float xp = __shfl_xor(x[j], 2); const int fi = (e & 1) * 8 + j;
                const float ang = pos * expf(-(float)fi * (9.210340371976184f / 16.0f)); const float cs = cosf(ang), sn = sinf(ang);
                x[j] = (e & 2) ? (x[j] * cs + xp * sn) : (x[j] * cs - xp * sn); }
        }
        const u32x4 w = pack8(x);
        if (isq) *(u32x4*)(QB + (size_t)row * 512 + hh * 64 + e * 8) = w;
        else { *(u32x4*)(KB + (size_t)row * 128 + (hh - 8) * 64 + e * 8) = w;
            if (!lat) { const int b = row >> 8, sq = row & 255; float* o = p.out + OUT_K + ((size_t)(b * 2 + l) * 256 + sq) * 128 + (hh - 8) * 64 + e * 8;
                *(f32x4*)o = (f32x4){x[0], x[1], x[2], x[3]}; *(f32x4*)(o + 4) = (f32x4){x[4], x[5], x[6], x[7]}; } }
    }
}

__device__ void chunk_item(const Params& p, LAS unsigned char* lds, int l, int tile, int ch) {
    const int tid = otid(); int rowbase, L, s0; tile_info(tile * 64, rowbase, L, s0);
    const bf16_t* U = (const bf16_t*)(p.ws + WS_U);
    LAS bf16_t* T = (LAS bf16_t*)lds;
    { const int t = tid >> 3, cs = tid & 7, s = s0 + t, row = tile * 64 + t; float v[16];
      if (ch == 0) { const int col0 = 896 + cs * 16;
          unpack8(*(const u32x4*)(U + (size_t)row * 1792 + col0), v); unpack8(*(const u32x4*)(U + (size_t)row * 1792 + col0 + 8), v + 8);
          if (L == 256) { const int b = row >> 8, sq = row & 255; float* o = p.out + OUT_V + ((size_t)(b * 2 + l) * 256 + sq) * 128 + cs * 16;
#pragma unroll
              for (int q = 0; q < 4; ++q) *(f32x4*)(o + q * 4) = (f32x4){v[q * 4], v[q * 4 + 1], v[q * 4 + 2], v[q * 4 + 3]}; } }
      else { const int cc0 = (ch - 1) * 128 + cs * 16, col0 = 1024 + cc0; float a[16], b[16], c[16];
          unpack8(*(const u32x4*)(U + (size_t)row * 1792 + col0), b); unpack8(*(const u32x4*)(U + (size_t)row * 1792 + col0 + 8), b + 8);
          if (s > 0) { unpack8(*(const u32x4*)(U + (size_t)(row - 1) * 1792 + col0), a); unpack8(*(const u32x4*)(U + (size_t)(row - 1) * 1792 + col0 + 8), a + 8); }
          else {
#pragma unroll
              for (int j = 0; j < 16; ++j) a[j] = 0.f; }
          if (s < L - 1) { unpack8(*(const u32x4*)(U + (size_t)(row + 1) * 1792 + col0), c); unpack8(*(const u32x4*)(U + (size_t)(row + 1) * 1792 + col0 + 8), c + 8); }
          else {
#pragma unroll
              for (int j = 0; j < 16; ++j) c[j] = 0.f; }
          const float* sw = p.in[19] + (size_t)l * 3 * 768 + cc0; const float* sb = p.in[20] + l * 768 + cc0;
#pragma unroll
          for (int j = 0; j < 16; ++j) v[j] = a[j] * sw[j] + b[j] * sw[768 + j] + c[j] * sw[1536 + j] + sb[j]; }
      *(LAS u32x4*)(T + t * 136 + cs * 16) = pack8(v); *(LAS u32x4*)(T + t * 136 + cs * 16 + 8) = pack8(v + 8); }
    __syncthreads();
    { const int col = tid >> 2, qd = tid & 3; bf16_t* dst;
      if (ch == 0) dst = (bf16_t*)(p.ws + WS_VT) + (size_t)rowbase * 128 + (size_t)col * L;
      else { const int cc = (ch - 1) * 128 + col, which = cc >> 8, c = cc & 255; dst = (bf16_t*)(p.ws + (which == 0 ? WS_HV : (which == 1 ? WS_X1 : WS_X2))) + (size_t)rowbase * 256 + (size_t)c * L; }
      unsigned w[8];
#pragma unroll
      for (int i = 0; i < 8; ++i) { const unsigned lo = T[(qd * 16 + 2 * i) * 136 + col], hi = T[(qd * 16 + 2 * i + 1) * 136 + col]; w[i] = lo | (hi << 16); }
      *(u32x4*)(dst + s0 + qd * 16) = (u32x4){w[0], w[1], w[2], w[3]}; *(u32x4*)(dst + s0 + qd * 16 + 8) = (u32x4){w[4], w[5], w[6], w[7]}; }
    __syncthreads();
}

__device__ void ph_mixprep(const Params& p, LAS unsigned char* lds, int l) {
    for (int it = blockIdx.x; it < 320 * 12; it += gridDim.x) { const int tile = it / 12, sub = it % 12;
        if (sub < 4) pool_item(p, lds, l, tile, sub);
        else if (sub == 4) qk_item(p, l, tile);
        else chunk_item(p, lds, l, tile, sub - 5); }
}

__device__ void attn_item(const Params& p, LAS unsigned char* lds, int l, bool lat, int b, int nb, int half, int kvh) {
    const int tid = otid(), lane = tid & 63, wave = tid >> 6, r = lane & 31, h = lane >> 5;
    const int gq = wave >> 1, hq = kvh * 4 + gq;
    const int L = lat ? 4096 : 256, rowbase = lat ? MPR + b * 4096 : b * 256;
    const bf16_t* QB = (const bf16_t*)(p.ws + WS_QB); const bf16_t* KB = (const bf16_t*)(p.ws + WS_KB); const bf16_t* VT = (const bf16_t*)(p.ws + WS_VT);
    int klo = 0, nt1 = 0; const bf16_t *K1 = KB, *V1 = VT, *K2, *V2;
    if (lat) { klo = max(0, (nb - 1) * 128); const int khi = min(L, (nb + 2) * 128); nt1 = (khi - klo) >> 6;
        K1 = KB + (size_t)(rowbase + klo) * 128 + kvh * 64; V1 = VT + (size_t)rowbase * 128 + (size_t)(kvh * 64) * L + klo;
        K2 = (const bf16_t*)(p.ws + WS_KC) + (size_t)((l * 4 + b) * 256) * 128 + kvh * 64; V2 = (const bf16_t*)(p.ws + WS_VCT) + (size_t)((l * 4 + b) * 128 + kvh * 64) * 256; }
    else { K2 = KB + (size_t)rowbase * 128 + kvh * 64; V2 = VT + (size_t)rowbase * 128 + (size_t)(kvh * 64) * 256; }
    LAS bf16_t* Ks = (LAS bf16_t*)lds;
    LAS bf16_t* Vs = (LAS bf16_t*)(lds + 64 * 72 * 2);
    const int qoff = nb * 128 + half * 64 + (wave & 1) * 32; const int qrow0 = rowbase + qoff;
    bf16x8 Q[4];
#pragma unroll
    for (int ks = 0; ks < 4; ++ks) Q[ks] = *(const bf16x8*)(QB + (size_t)(qrow0 + r) * 512 + hq * 64 + 16 * ks + 8 * h);
    f32x16 O[2];
#pragma unroll
    for (int a = 0; a < 2; ++a)
#pragma unroll
        for (int q = 0; q < 16; ++q) O[a][q] = 0.f;
    const float sinkv = p.in[18][l * 8 + hq];
    float mrun = sinkv, lsum = h == 0 ? 1.f : 0.f;
    const int ldrow = tid >> 3, ldseg = tid & 7;
    for (int ti = 0; ti < nt1 + 4; ++ti) {
        const bool masked = ti < nt1; const bf16_t *Kp, *Vp; int vs, kpos0 = 0;
        if (masked) { Kp = K1 + (size_t)ti * 64 * 128; Vp = V1 + ti * 64; vs = L; kpos0 = klo + ti * 64; } else { const int j = ti - nt1; Kp = K2 + (size_t)j * 64 * 128; Vp = V2 + j * 64; vs = 256; }
        const u32x4 kreg = *(const u32x4*)(Kp + (size_t)ldrow * 128 + ldseg * 8), vreg = *(const u32x4*)(Vp + (size_t)ldrow * vs + ldseg * 8);
        __syncthreads();
        *(LAS u32x4*)(Ks + ldrow * 72 + ldseg * 8) = kreg; *(LAS u32x4*)(Vs + ldrow * 72 + ldseg * 8) = vreg;
        __syncthreads();
        {
            f32x16 S[2];
#pragma unroll
            for (int kb2 = 0; kb2 < 2; ++kb2) {
#pragma unroll
                for (int q = 0; q < 16; ++q) S[kb2][q] = 0.f;
#pragma unroll
                for (int ks = 0; ks < 4; ++ks) { const bf16x8 kf = *(const LAS bf16x8*)(Ks + (32 * kb2 + r) * 72 + 16 * ks + 8 * h);
                    S[kb2] = __builtin_amdgcn_mfma_f32_32x32x16_bf16(kf, Q[ks], S[kb2], 0, 0, 0); } }
            const int qpos = qoff + r;
            float mx = -3.0e38f;
#pragma unroll
            for (int kb2 = 0; kb2 < 2; ++kb2)
#pragma unroll
                for (int q = 0; q < 16; ++q) { float sv = S[kb2][q] * 0.125f;
                    if (masked) { const int kpos = kpos0 + 32 * kb2 + (q & 3) + 8 * (q >> 2) + 4 * h; const int df = kpos - qpos; if (df > 128 || df < -128) sv = -1.0e30f; }
                    S[kb2][q] = sv; mx = fmaxf(mx, sv); }
            mx = fmaxf(mx, __shfl_xor(mx, 32));
            const float mnew = fmaxf(mrun, mx), alpha = __expf(mrun - mnew); mrun = mnew;
            float psum = 0.f;
#pragma unroll
            for (int kb2 = 0; kb2 < 2; ++kb2)
#pragma unroll
                for (int q = 0; q < 16; ++q) { const float pv = __expf(S[kb2][q] - mnew); S[kb2][q] = pv; psum += pv; }
            lsum = lsum * alpha + psum;
#pragma unroll
            for (int db = 0; db < 2; ++db)
#pragma unroll
                for (int q = 0; q < 16; ++q) O[db][q] *= alpha;
#pragma unroll
            for (int kb2 = 0; kb2 < 2; ++kb2)
#pragma unroll
                for (int s = 0; s < 2; ++s) { u32x4 pw; pw.x = pk(S[kb2][8 * s], S[kb2][8 * s + 1]); pw.y = pk(S[kb2][8 * s + 2], S[kb2][8 * s + 3]); pw.z = pk(S[kb2][8 * s + 4], S[kb2][8 * s + 5]); pw.w = pk(S[kb2][8 * s + 6], S[kb2][8 * s + 7]);
                    const bf16x8 pf = __builtin_bit_cast(bf16x8, pw);
#pragma unroll
                    for (int db = 0; db < 2; ++db) { const LAS bf16_t* vp = Vs + (32 * db + r) * 72 + 32 * kb2 + 16 * s + 4 * h;
                        const u32x2 v0 = *(const LAS u32x2*)vp, v1 = *(const LAS u32x2*)(vp + 8); const u32x4 vw = (u32x4){v0.x, v0.y, v1.x, v1.y};
                        O[db] = __builtin_amdgcn_mfma_f32_32x32x16_bf16(__builtin_bit_cast(bf16x8, vw), pf, O[db], 0, 0, 0); } }
        }
    }
    bf16_t* MX = (bf16_t*)(p.ws + WS_ABUF);
    { const float lt = lsum + __shfl_xor(lsum, 32); const float inv = 1.0f / lt;
        bf16_t* orow = MX + (size_t)(qrow0 + r) * 1024 + 256 + hq * 64;
#pragma unroll
        for (int db = 0; db < 2; ++db)
#pragma unroll
            for (int g4 = 0; g4 < 4; ++g4) { u32x2 w; w.x = pk(O[db][4 * g4] * inv, O[db][4 * g4 + 1] * inv); w.y = pk(O[db][4 * g4 + 2] * inv, O[db][4 * g4 + 3] * inv);
                *(u32x2*)(orow + 32 * db + 8 * g4 + 4 * h) = w; } }
    __syncthreads();
}

__device__ void conv_item(const Params& p, LAS unsigned char* lds, int l, bool smp, int c, int order) {
    const int tid = otid(), lane = tid & 63, wave = tid >> 6, r = lane & 31, h = lane >> 5;
    const int L = smp ? 4096 : 256, NB = smp ? 4 : 16, rowbase0 = smp ? MPR : 0, Lsel = smp ? 1 : 0;
    const int nblk = L >> 5, Iper = 32 / NB, npairs = nblk / (2 * Iper);
    constexpr int PADE = 480;
    const int zstride = L + 2 * PADE + 72;
    LAS bf16_t* zs = (LAS bf16_t*)lds;
    const int CPS = 2 * L + 16;
    LAS bf16_t* cp = (LAS bf16_t*)(lds + (size_t)NB * zstride * 2);
    const bf16_t* zin = (const bf16_t*)(p.ws + (order == 0 ? WS_HV : WS_Z1));
    const bf16_t* gate = (const bf16_t*)(p.ws + (order == 0 ? WS_X1 : WS_X2));
    const bf16_t* filt = filt_ptr(p, l, Lsel) + (size_t)(order * 256 + c) * (2 * L);
    const float fs = ((const float*)(p.ws + WS_FSC))[((l * 2 + Lsel) * 2 + order) * 256 + c];
    const float bd = p.in[29][l * 512 + order * 256 + c];
    const int nch = L >> 3;
    for (int i = tid; i < NB * nch; i += NTHR) { const int b = i / nch, ch = i % nch;
        *(LAS u32x4*)(zs + b * zstride + PADE + ch * 8) = *(const u32x4*)(zin + (size_t)(rowbase0 + b * L) * 256 + (size_t)c * L + ch * 8); }
    for (int i = tid; i < NB * 120; i += NTHR) { const int b = i / 120, q = i % 120; const int off = q < 60 ? q * 8 : PADE + L + (q - 60) * 8;
        *(LAS u32x4*)(zs + b * zstride + off) = (u32x4){0u, 0u, 0u, 0u}; }
    { typedef unsigned u32x4u __attribute__((ext_vector_type(4), aligned(4)));
      const int ncq = CPS >> 3; const unsigned* fw = (const unsigned*)filt;
      for (int i = tid; i < 4 * ncq; i += NTHR) { const int a2 = i / ncq, q = i % ncq; const int idx = 8 * q + 2 * a2;
          u32x4 v;
          if (idx + 8 <= 2 * L) v = *(const u32x4u*)(fw + (idx >> 1));
          else { v.x = idx < 2 * L ? fw[idx >> 1] : 0u; v.y = idx + 2 < 2 * L ? fw[(idx >> 1) + 1] : 0u; v.z = idx + 4 < 2 * L ? fw[(idx >> 1) + 2] : 0u; v.w = idx + 6 < 2 * L ? fw[(idx >> 1) + 3] : 0u; }
          *(LAS u32x4*)(cp + a2 * CPS + 8 * q) = v; } }
    __syncthreads();
    const int bcol = r % NB, Iloc = r / NB;
    const int sa = (-r) & 7; const unsigned sh16 = (unsigned)(sa & 1) * 16u; const LAS bf16_t* cpl = cp + (sa >> 1) * CPS;
    for (int gp = wave; gp < npairs; gp += 8) {
        const int I0a = 2 * gp * Iper, I0b = I0a + Iper;
        f32x16 acc[2];
#pragma unroll
        for (int q = 0; q < 16; ++q) { acc[0][q] = 0.f; acc[1][q] = 0.f; }
        const int Dlo = I0a - (nblk - 1), Dhi = I0b + Iper - 1;
        const LAS bf16_t* zb = zs + bcol * zstride + PADE + 8 * h;
        for (int D = Dlo; D <= Dhi; ++D) {
            const int base = L - 32 * D - r + 8 * h - sa;
            bf16x8 af[2];
#pragma unroll
            for (int ks = 0; ks < 2; ++ks) { const LAS bf16_t* q = cpl + base + 16 * ks; const u32x4 w = *(const LAS u32x4*)q; const unsigned w4 = *(const LAS unsigned*)(q + 8);
                const u32x4 aw = (u32x4){__builtin_amdgcn_alignbit(w.y, w.x, sh16), __builtin_amdgcn_alignbit(w.z, w.y, sh16), __builtin_amdgcn_alignbit(w.w, w.z, sh16), __builtin_amdgcn_alignbit(w4, w.w, sh16)};
                af[ks] = __builtin_bit_cast(bf16x8, aw); }
#pragma unroll
            for (int x = 0; x < 2; ++x) { const int J = (x ? I0b : I0a) + Iloc - D;
#pragma unroll
                for (int ks = 0; ks < 2; ++ks) { const bf16x8 bfr = *(const LAS bf16x8*)(zb + 32 * J + 16 * ks);
                    acc[x] = __builtin_amdgcn_mfma_f32_32x32x16_bf16(af[ks], bfr, acc[x], 0, 0, 0); } }
        }
#pragma unroll
        for (int x = 0; x < 2; ++x) { const int I = (x ? I0b : I0a) + Iloc; const int rb = rowbase0 + bcol * L;
#pragma unroll
            for (int g4 = 0; g4 < 4; ++g4) { const int t0 = 32 * I + 8 * g4 + 4 * h;
                const u32x2 zc = *(const LAS u32x2*)(zs + bcol * zstride + PADE + t0);
                const size_t gi = (size_t)rb * 256 + (size_t)c * L + t0;
                const u32x2 gw = *(const u32x2*)(gate + gi);
                float o[4];
                o[0] = bflo(gw.x) * (acc[x][4 * g4] * fs + bd * bflo(zc.x)); o[1] = bfhi(gw.x) * (acc[x][4 * g4 + 1] * fs + bd * bfhi(zc.x));
                o[2] = bflo(gw.y) * (acc[x][4 * g4 + 2] * fs + bd * bflo(zc.y)); o[3] = bfhi(gw.y) * (acc[x][4 * g4 + 3] * fs + bd * bfhi(zc.y));
                if (order == 0) { u32x2 w; w.x = pk(o[0], o[1]); w.y = pk(o[2], o[3]); *(u32x2*)((bf16_t*)(p.ws + WS_Z1) + gi) = w; }
                else { bf16_t* mp = (bf16_t*)(p.ws + WS_ABUF) + (size_t)(rb + t0) * 1024 + 768 + c;
#pragma unroll
                    for (int j = 0; j < 4; ++j) mp[(size_t)j * 1024] = f2bf(o[j]); } } }
    }
    __syncthreads();
}

__device__ void ph_attn_conv1(const Params& p, LAS unsigned char* lds, int l) {
    for (int it = blockIdx.x; it < 1152; it += gridDim.x) {
        if (it < 256) conv_item(p, lds, l, true, it, 0);
        else if (it < 768) { const int a = it - 256; attn_item(p, lds, l, true, a >> 7, (a >> 2) & 31, (a >> 1) & 1, a & 1); }
        else if (it < 1024) conv_item(p, lds, l, false, it - 768, 0);
        else { const int a = it - 1024; attn_item(p, lds, l, false, a >> 3, (a >> 2) & 1, (a >> 1) & 1, a & 1); }
    }
}
__device__ void ph_conv2(const Params& p, LAS unsigned char* lds, int l) {
    for (int it = blockIdx.x; it < 512; it += gridDim.x) conv_item(p, lds, l, it < 256, it & 255, 1);
}

#ifndef PH_MASK
#define PH_MASK 0xffff
#endif
#define EN(x) (((PH_MASK) >> (x)) & 1)
#ifndef REP_MASK
#define REP_MASK 0
#endif
#define RP(x) (((REP_MASK) >> (x)) & 1)
__device__ __forceinline__ int ph_cat(int s) { return s == 0 ? 1 : s == 1 ? 2 : s == 2 ? 3 : s == 3 ? 1 : s == 4 ? 4 : s == 5 ? 5 : s == 6 ? 6 : s == 7 ? 7 : s == 8 ? 8 : s == 9 ? 1 : s == 10 ? 2 : 3; }
template <class Epi>
__device__ __forceinline__ void run_gemm(LAS unsigned char* lds, const bf16_t* A, const bf16_t* Bt, int N, int K, const Epi& E) {
    pg8::Gemm g{A, Bt, MTOK, N, K}; pg8::StaticOrder S; S.init(MTOK, N, (int)gridDim.x, (int)blockIdx.x);
    pg8::gemm_phase<Epi, pg8::StaticOrder>(lds, g, S, E);
}

__global__ void __launch_bounds__(NTHR) mega(Params p) {
    extern __shared__ __attribute__((aligned(16))) unsigned char smem[];
    LAS unsigned char* lds = (LAS unsigned char*)smem;
    cg::grid_group grid = cg::this_grid();
    volatile LAS unsigned* bst = (volatile LAS unsigned*)(lds + 131072);
    if (threadIdx.x == 0) { bst[0] = 0u; bst[1] = 0u; }
    __syncthreads();
    XcdBarrier xbar = xcd_barrier_post((unsigned*)(p.ws + WS_BAR), bst);
    float* X = p.out; const float* mod = (const float*)(p.ws + WS_MOD);
    bf16_t* AB = (bf16_t*)(p.ws + WS_ABUF);
    for (int ph = p.ph_lo; ph < p.ph_hi; ++ph) {
      const int cat_ = ph == 0 ? 0 : (((ph - 1) % 12 == 0 && ph == 1) ? 9 : ph_cat((ph - 1) % 12));
      for (int rep_ = 0; rep_ < 1 + RP(cat_); ++rep_) {
        if (ph == 0) { if (EN(0)) ph_prep(p, lds); }
        else {
            const int l = (ph - 1) / 12, s = (ph - 1) % 12;
            const float* xp = (l == 0 && s < 3) ? p.in[0] : X; const float* xs = (l == 0 && s < 3) ? p.in[1] : X + (size_t)MPR * 1024;
            const float* ml = mod + (size_t)l * 5 * 9216;
            switch (s) {
            case 0: if (EN(1)) { if (l == 0) { for (int it = blockIdx.x; it < 512; it += gridDim.x) filter_item(p, lds, it); } }
                    if (EN(2)) ph_norm(p, l, 0, xp, xs); break;
            case 1: if (EN(3)) run_gemm(lds, AB, (const bf16_t*)(p.ws + WS_WGU + (size_t)(l * 2) * SZ_WGU), 5632, 1024, EpiSwiglu{(bf16_t*)(p.ws + WS_ACT)}); break;
            case 2: if (EN(4)) run_gemm(lds, (const bf16_t*)(p.ws + WS_ACT), (const bf16_t*)(p.ws + WS_WD + (size_t)(l * 2) * SZ_WD), 1024, 2816, EpiResid{xp, xs, X, ml + 2 * 1024, 0.5f}); break;
            case 3: if (EN(2)) ph_norm(p, l, 1, X, X + (size_t)MPR * 1024); break;
            case 4: if (EN(5)) run_gemm(lds, AB, (const bf16_t*)(p.ws + WS_WIN + (size_t)l * SZ_WIN), 1792, 1024, EpiStore{(bf16_t*)(p.ws + WS_U), 1792}); break;
            case 5: if (EN(6)) ph_mixprep(p, lds, l); break;
            case 6: if (EN(7)) ph_attn_conv1(p, lds, l); break;
            case 7: if (EN(8)) ph_conv2(p, lds, l); break;
            case 8: if (EN(4)) run_gemm(lds, AB, (const bf16_t*)(p.ws + WS_WOUT + (size_t)l * SZ_WOUT), 1024, 1024, EpiResid{X, X + (size_t)MPR * 1024, X, ml + 5 * 1024, 1.0f}); break;
            case 9: if (EN(2)) ph_norm(p, l, 2, X, X + (size_t)MPR * 1024); break;
            case 10: if (EN(3)) run_gemm(lds, AB, (const bf16_t*)(p.ws + WS_WGU + (size_t)(l * 2 + 1) * SZ_WGU), 5632, 1024, EpiSwiglu{(bf16_t*)(p.ws + WS_ACT)}); break;
            default: if (EN(4)) run_gemm(lds, (const bf16_t*)(p.ws + WS_ACT), (const bf16_t*)(p.ws + WS_WD + (size_t)(l * 2 + 1) * SZ_WD), 1024, 2816, EpiResid{X, X + (size_t)MPR * 1024, X, ml + 8 * 1024, 0.5f}); break;
            }
        }
      }
        if (ph + 1 < p.ph_hi) { if (ph == 0) grid.sync(); else xcd_barrier(xbar); if (RP(15)) xcd_barrier(xbar); }
    }
}

#ifndef MK_MULTI
#define MK_MULTI 0
#endif
extern "C" void kernel_launch(void* const* d_in, const int* in_sizes, int n_in, void* d_out, int out_size, void* d_ws, size_t ws_size, hipStream_t stream) {
    static int grid = 0;
    if (grid == 0) {
        if (n_in != 30 || ws_size < WS_END2) { fprintf(stderr, "kernel_launch: bad arguments: n_in %d ws %zu (need %zu)\n", n_in, ws_size, (size_t)WS_END2); grid = -1; return; }
        int dev = 0, cus = 0, per_cu = 0;
        hipGetDevice(&dev); hipDeviceGetAttribute(&cus, hipDeviceAttributeMultiprocessorCount, dev);
        if (hipFuncSetAttribute((const void*)mega, hipFuncAttributeMaxDynamicSharedMemorySize, LDS_BYTES) != hipSuccess) { fprintf(stderr, "kernel_launch: hipFuncSetAttribute failed\n"); grid = -1; return; }
        if (hipOccupancyMaxActiveBlocksPerMultiprocessor(&per_cu, (const void*)mega, NTHR, LDS_BYTES) != hipSuccess || per_cu < 1) { fprintf(stderr, "kernel_launch: occupancy query says %d\n", per_cu); per_cu = 1; }
        (void)hipGetLastError();
        grid = cus * 1;
    }
    if (grid < 0) return;
    Params prm{};
    for (int i = 0; i < 30; ++i) prm.in[i] = (const float*)d_in[i];
    prm.out = (float*)d_out; prm.ws = (unsigned char*)d_ws;
#if MK_MULTI
    for (int ph = 0; ph < NPH; ++ph) { prm.ph_lo = ph; prm.ph_hi = ph + 1; hipLaunchKernelGGL(mega, dim3(grid), dim3(NTHR), LDS_BYTES, stream, prm); }
#else
    prm.ph_lo = 0; prm.ph_hi = NPH;
    if (hipMemsetAsync((unsigned char*)d_ws + WS_BAR, 0, (size_t)XCD_BAR_WORDS * 4, stream) != hipSuccess) { fprintf(stderr, "kernel_launch: memset of the barrier words failed\n"); return; }
    void* args[] = {&prm};
    hipError_t e = hipLaunchCooperativeKernel((const void*)mega, dim3(grid), dim3(NTHR), args, LDS_BYTES, stream);
    if (e != hipSuccess) fprintf(stderr, "cooperative launch failed: %s (grid %d)\n", hipGetErrorString(e), grid);
#endif
}
```
